# Optimizing an MI355X kernel written in HIP

```python
import math
import jax, jax.numpy as jnp
from jax import lax
import numpy as np

D_MODEL = 1024
BATCH = 2
SEQ = 16384
DEPTH = 1
DEC_BATCH = 8
DEC_SEQ = 64
PAST_LEN = 2048

CHUNK = 64
LEFT_CHUNKS = 8
BAND_CHUNKS = LEFT_CHUNKS + 1
BAND = BAND_CHUNKS * CHUNK
ATT_REACH = LEFT_CHUNKS * CHUNK
MIX_WIDTH = D_MODEL
ATT_WIDTH = MIX_WIDTH // 2
MLSTM_WIDTH = MIX_WIDTH - ATT_WIDTH
ATT_HEADS = 8
ATT_HEAD_DIM = ATT_WIDTH // ATT_HEADS
MLSTM_HEADS = 4
MLSTM_HEAD_DIM = MLSTM_WIDTH // MLSTM_HEADS
MAX_REL = 128
D_FF = 4 * D_MODEL
DEEPNORM_ALPHA = (2 * DEPTH) ** 0.25
DEEPNORM_BETA = (8 * DEPTH) ** -0.25
LN_EPS = 1e-5
NEG_INF = -1e30
ATT_SCALE = ATT_HEAD_DIM ** -0.5

OFF_QA = 0
OFF_KA = OFF_QA + ATT_WIDTH
OFF_VA = OFF_KA + ATT_WIDTH
OFF_QB = OFF_VA + ATT_WIDTH
OFF_KB = OFF_QB + MLSTM_WIDTH
OFF_VB = OFF_KB + MLSTM_WIDTH
OFF_OB = OFF_VB + MLSTM_WIDTH
OFF_IG = OFF_OB + MLSTM_WIDTH
OFF_FG = OFF_IG + MLSTM_HEADS
IN_WIDTH = OFF_FG + MLSTM_HEADS

kernel_name = "hybrid_band_attn_mlstm_stream_step"


def layer_norm(x, g, b):
    xf = x.astype(jnp.float32)
    mu = xf.mean(-1, keepdims=True)
    var = jnp.square(xf - mu).mean(-1, keepdims=True)
    return ((xf - mu) * lax.rsqrt(var + LN_EPS) * g + b).astype(x.dtype)


def head_norm(h, g):
    mu = h.mean(-1, keepdims=True)
    var = jnp.square(h - mu).mean(-1, keepdims=True)
    hn = (h - mu) * lax.rsqrt(var + LN_EPS)
    B, T = h.shape[0], h.shape[1]
    return hn.reshape(B, T, MLSTM_WIDTH) * g.astype(jnp.float32)


def rel_bias_lookup(rel_bias, rel):
    return rel_bias[:, jnp.clip(rel, -MAX_REL, MAX_REL) + MAX_REL].astype(jnp.float32)


def in_projection(x, w_in, b_in):
    u = jnp.einsum('btd,de->bte', x, w_in) + b_in
    B, T = u.shape[0], u.shape[1]

    def heads(off, width, nh):
        return u[..., off:off + width].reshape(B, T, nh, width // nh)

    qa = heads(OFF_QA, ATT_WIDTH, ATT_HEADS)
    ka = heads(OFF_KA, ATT_WIDTH, ATT_HEADS)
    va = heads(OFF_VA, ATT_WIDTH, ATT_HEADS)
    qb = heads(OFF_QB, MLSTM_WIDTH, MLSTM_HEADS).astype(jnp.float32)
    kb = heads(OFF_KB, MLSTM_WIDTH, MLSTM_HEADS).astype(jnp.float32) * (MLSTM_HEAD_DIM ** -0.5)
    vb = heads(OFF_VB, MLSTM_WIDTH, MLSTM_HEADS).astype(jnp.float32)
    og = jax.nn.sigmoid(u[..., OFF_OB:OFF_OB + MLSTM_WIDTH])
    ig = u[..., OFF_IG:OFF_IG + MLSTM_HEADS].astype(jnp.float32)
    lf = jax.nn.log_sigmoid(u[..., OFF_FG:OFF_FG + MLSTM_HEADS].astype(jnp.float32))
    return qa, ka, va, qb, kb, vb, og, ig, lf


def band_attention_prompt(q, k, v, rel_bias):
    B, S, H, Dh = q.shape
    nc = S // CHUNK
    pad = LEFT_CHUNKS * CHUNK
    qc = q.reshape(B, nc, CHUNK, H, Dh)
    kp = jnp.pad(k, ((0, 0), (pad, 0), (0, 0), (0, 0))).reshape(B, nc + LEFT_CHUNKS, CHUNK, H, Dh)
    vp = jnp.pad(v, ((0, 0), (pad, 0), (0, 0), (0, 0))).reshape(B, nc + LEFT_CHUNKS, CHUNK, H, Dh)
    s = jnp.concatenate(
        [jnp.einsum('bcqhd,bckhd->bchqk', qc, kp[:, j:j + nc]) for j in range(BAND_CHUNKS)],
        axis=-1).astype(jnp.float32) * ATT_SCALE
    qi = jnp.arange(CHUNK)
    kj = jnp.arange(BAND)
    rel = pad + qi[:, None] - kj[None, :]
    s = s + rel_bias_lookup(rel_bias, rel)[None, None]
    kpos = (jnp.arange(nc)[:, None] - LEFT_CHUNKS) * CHUNK + kj[None, :]
    s = jnp.where((kpos >= 0)[None, :, None, None, :], s, NEG_INF)
    p = jax.nn.softmax(s, axis=-1).astype(v.dtype).reshape(B, nc, H, CHUNK, BAND_CHUNKS, CHUNK)
    o = jnp.einsum('bchqk,bckhd->bcqhd', p[..., 0, :], vp[:, 0:nc])
    for j in range(1, BAND_CHUNKS):
        o = o + jnp.einsum('bchqk,bckhd->bcqhd', p[..., j, :], vp[:, j:j + nc])
    return o.reshape(B, S, H * Dh)


def band_attention_sample(q, k_new, v_new, cache_k, cache_v, rel_bias):
    DB, T, H, Dh = q.shape
    R = cache_k.shape[1]
    kk = jnp.concatenate([cache_k.astype(k_new.dtype), k_new], axis=1)
    vv = jnp.concatenate([cache_v.astype(v_new.dtype), v_new], axis=1)
    s = jnp.einsum('bqhd,bkhd->bhqk', q, kk).astype(jnp.float32) * ATT_SCALE
    rel = jnp.arange(T)[:, None] + R - jnp.arange(R + T)[None, :]
    s = s + rel_bias_lookup(rel_bias, rel)[None]
    p = jax.nn.softmax(s, axis=-1).astype(vv.dtype)
    o = jnp.einsum('bhqk,bkhd->bqhd', p, vv)
    return o.reshape(DB, T, H * Dh)


def mlstm_block(C, n, m, q, k, v, ig, lf):
    L = q.shape[2]
    b = jnp.cumsum(lf, axis=-1)
    causal = jnp.tril(jnp.ones((L, L), dtype=bool))
    logw = jnp.where(causal, b[..., :, None] - b[..., None, :] + ig[..., None, :], -jnp.inf)
    inter = b + m[..., None]
    m_t = jnp.maximum(inter, logw.max(-1))
    w = jnp.exp(logw - m_t[..., None]) * jnp.einsum('bhtd,bhsd->bhts', q, k)
    g = jnp.exp(inter - m_t)
    num = g[..., None] * jnp.einsum('bhvk,bhtk->bhtv', C, q) + jnp.einsum('bhts,bhsv->bhtv', w, v)
    den = g * jnp.einsum('bhk,bhtk->bht', n, q) + w.sum(-1)
    h = num / jnp.maximum(jnp.abs(den), jnp.exp(-m_t))[..., None]
    b_last = b[..., -1]
    logw_end = b_last[..., None] - b + ig
    m_new = jnp.maximum(b_last + m, logw_end.max(-1))
    decay = jnp.exp(b_last + m - m_new)
    w_end = jnp.exp(logw_end - m_new[..., None])
    C_new = decay[..., None, None] * C + jnp.einsum('bhs,bhsv,bhsk->bhvk', w_end, v, k)
    n_new = decay[..., None] * n + jnp.einsum('bhs,bhsk->bhk', w_end, k)
    return C_new, n_new, m_new, h


def mlstm_prompt(q, k, v, ig, lf):
    B, S, H, d = q.shape
    nc = S // CHUNK

    def blocks(t):
        return t.reshape(B, nc, CHUNK, H, d).transpose(1, 0, 3, 2, 4)

    def gblocks(t):
        return t.reshape(B, nc, CHUNK, H).transpose(1, 0, 3, 2)

    init = (jnp.zeros((B, H, d, d), jnp.float32), jnp.zeros((B, H, d), jnp.float32),
            jnp.zeros((B, H), jnp.float32))

    def step(carry, xs):
        C, n, m = carry
        C, n, m, h = mlstm_block(C, n, m, *xs)
        return (C, n, m), h

    (C, n, m), hs = lax.scan(step, init, (blocks(q), blocks(k), blocks(v), gblocks(ig), gblocks(lf)))
    h = hs.transpose(1, 0, 3, 2, 4).reshape(B, S, H, d)
    return h, C, n, m


def mlstm_sample(q, k, v, ig, lf, C, n, m):
    C, n, m, h = mlstm_block(C.astype(jnp.float32), n.astype(jnp.float32), m.astype(jnp.float32),
                             jnp.swapaxes(q, 1, 2), jnp.swapaxes(k, 1, 2), jnp.swapaxes(v, 1, 2),
                             jnp.swapaxes(ig, 1, 2), jnp.swapaxes(lf, 1, 2))
    return jnp.swapaxes(h, 1, 2), C, n, m


def merge_and_ffn(x, att_o, mlstm_h, og, norm_g, w_out, ln1_g, ln1_b, w_ff1, b_ff1, w_ff2, b_ff2, ln2_g, ln2_b):
    mb = (og.astype(jnp.float32) * head_norm(mlstm_h, norm_g)).astype(x.dtype)
    mix = jnp.einsum('bte,ed->btd', jnp.concatenate([att_o.astype(x.dtype), mb], axis=-1), w_out)
    h = layer_norm(DEEPNORM_ALPHA * x + mix, ln1_g, ln1_b)
    f = jnp.einsum('btf,fd->btd', jnp.square(jax.nn.relu(jnp.einsum('btd,df->btf', h, w_ff1) + b_ff1)), w_ff2) + b_ff2
    return layer_norm(DEEPNORM_ALPHA * h + f, ln2_g, ln2_b)


def setup_inputs(seed: int = 0) -> dict:
    key = jax.random.key(seed)
    ks = jax.random.split(key, 24)
    f32 = jnp.float32
    rows = min(ATT_REACH, PAST_LEN)
    beta = DEEPNORM_BETA
    col_scale = (jnp.ones((IN_WIDTH,), f32)
                 .at[OFF_VA:OFF_VA + ATT_WIDTH].set(beta)
                 .at[OFF_VB:OFF_VB + MLSTM_WIDTH].set(beta))
    w_in = jax.random.normal(ks[7], (DEPTH, D_MODEL, IN_WIDTH), f32) * (D_MODEL ** -0.5) * col_scale
    b_in = (jax.random.normal(ks[8], (DEPTH, IN_WIDTH), f32) * 0.01).at[:, OFF_FG:OFF_FG + MLSTM_HEADS].add(
        jnp.linspace(3.0, 6.0, MLSTM_HEADS, dtype=f32))
    return {
        "x_prompt": jax.random.normal(ks[0], (BATCH, SEQ, D_MODEL), f32),
        "x_sample": jax.random.normal(ks[1], (DEC_BATCH, DEC_SEQ, D_MODEL), f32),
        "cache_k": jax.random.normal(ks[2], (DEPTH, DEC_BATCH, rows, ATT_HEADS, ATT_HEAD_DIM), f32),
        "cache_v": jax.random.normal(ks[3], (DEPTH, DEC_BATCH, rows, ATT_HEADS, ATT_HEAD_DIM), f32) * beta,
        "state_C": jax.random.normal(ks[4], (DEPTH, DEC_BATCH, MLSTM_HEADS, MLSTM_HEAD_DIM, MLSTM_HEAD_DIM), f32) * 0.1,
        "state_n": jax.random.normal(ks[5], (DEPTH, DEC_BATCH, MLSTM_HEADS, MLSTM_HEAD_DIM), f32) * 0.1,
        "state_m": jax.random.normal(ks[6], (DEPTH, DEC_BATCH, MLSTM_HEADS), f32) * 0.5,
        "w_in": w_in,
        "b_in": b_in,
        "rel_bias": jax.random.normal(ks[9], (DEPTH, ATT_HEADS, 2 * MAX_REL + 1), f32) * 0.1,
        "mlstm_norm_g": 1.0 + 0.02 * jax.random.normal(ks[10], (DEPTH, MLSTM_WIDTH), f32),
        "w_out": jax.random.normal(ks[11], (DEPTH, MIX_WIDTH, D_MODEL), f32) * (MIX_WIDTH ** -0.5) * beta,
        "ln1_g": 1.0 + 0.02 * jax.random.normal(ks[12], (DEPTH, D_MODEL), f32),
        "ln1_b": 0.02 * jax.random.normal(ks[13], (DEPTH, D_MODEL), f32),
        "w_ff1": jax.random.normal(ks[14], (DEPTH, D_MODEL, D_FF), f32) * (D_MODEL ** -0.5) * beta,
        "b_ff1": 0.01 * jax.random.normal(ks[15], (DEPTH, D_FF), f32),
        "w_ff2": jax.random.normal(ks[16], (DEPTH, D_FF, D_MODEL), f32) * (D_FF ** -0.5) * beta,
        "b_ff2": 0.01 * jax.random.normal(ks[17], (DEPTH, D_MODEL), f32),
        "ln2_g": 1.0 + 0.02 * jax.random.normal(ks[18], (DEPTH, D_MODEL), f32),
        "ln2_b": 0.02 * jax.random.normal(ks[19], (DEPTH, D_MODEL), f32),
    }


def reference(x_prompt, x_sample, cache_k, cache_v, state_C, state_n, state_m, w_in, b_in, rel_bias,
              mlstm_norm_g, w_out, ln1_g, ln1_b, w_ff1, b_ff1, w_ff2, b_ff2, ln2_g, ln2_b):
    sd = state_C.dtype
    yp, ys = x_prompt, x_sample
    kp_l, vp_l, Cp_l, np_l, mp_l = [], [], [], [], []
    ks_l, vs_l, Cs_l, ns_l, ms_l = [], [], [], [], []
    for l in range(DEPTH):
        qa, ka, va, qb, kb, vb, og, ig, lf = in_projection(yp, w_in[l], b_in[l])
        att = band_attention_prompt(qa, ka, va, rel_bias[l])
        hb, Cp, npr, mp = mlstm_prompt(qb, kb, vb, ig, lf)
        rows = min(ATT_REACH, yp.shape[1])
        kp_l.append(ka[:, yp.shape[1] - rows:].astype(cache_k.dtype))
        vp_l.append(va[:, yp.shape[1] - rows:].astype(cache_v.dtype))
        Cp_l.append(Cp.astype(sd))
        np_l.append(npr.astype(sd))
        mp_l.append(mp.astype(sd))
        yp = merge_and_ffn(yp, att, hb, og, mlstm_norm_g[l], w_out[l], ln1_g[l], ln1_b[l],
                           w_ff1[l], b_ff1[l], w_ff2[l], b_ff2[l], ln2_g[l], ln2_b[l])
        qa, ka, va, qb, kb, vb, og, ig, lf = in_projection(ys, w_in[l], b_in[l])
        att = band_attention_sample(qa, ka, va, cache_k[l], cache_v[l], rel_bias[l])
        hb, Cs, ns, ms = mlstm_sample(qb, kb, vb, ig, lf, state_C[l], state_n[l], state_m[l])
        ks_l.append(ka.astype(cache_k.dtype))
        vs_l.append(va.astype(cache_v.dtype))
        Cs_l.append(Cs.astype(sd))
        ns_l.append(ns.astype(sd))
        ms_l.append(ms.astype(sd))
        ys = merge_and_ffn(ys, att, hb, og, mlstm_norm_g[l], w_out[l], ln1_g[l], ln1_b[l],
                           w_ff1[l], b_ff1[l], w_ff2[l], b_ff2[l], ln2_g[l], ln2_b[l])
    return (yp, ys,
            jnp.stack(kp_l), jnp.stack(vp_l), jnp.stack(Cp_l), jnp.stack(np_l), jnp.stack(mp_l),
            jnp.stack(ks_l), jnp.stack(vs_l), jnp.stack(Cs_l), jnp.stack(ns_l), jnp.stack(ms_l))
```

```cpp
#include <hip/hip_runtime.h>
#include <hip/hip_cooperative_groups.h>
#include <cstdio>
#include <cstdint>
namespace cg = cooperative_groups;

#ifndef MK_N_LAUNCHES
#define MK_N_LAUNCHES 1
#endif

constexpr int DM = 1024, SEQ = 16384, NB = 2, DB = 8, DSEQ = 64;
constexpr int MP = NB * SEQ;
constexpr int MS = DB * DSEQ;
constexpr int MT = MP + MS;
constexpr int INW = 3592, NIN = 3584;
constexpr int AW = 512;
constexpr int FF = 4096;
constexpr int KVROWS = MP + DB * 576;
constexpr float LN_EPS = 1e-5f;
constexpr float ALPHA = 1.189207115002721f;
constexpr float LOG2E = 1.4426950408889634f;
constexpr float QSCALE = 0.125f * LOG2E;
constexpr float KBSCALE = 0.08838834764831845f;
constexpr size_t O_YP = 0, O_YS = 33554432, O_KP = 34078720, O_VP = 34603008, O_CP = 35127296, O_NP = 35258368, O_MP = 35259392,
                 O_KS = 35259400, O_VS = 35521544, O_CS = 35783688, O_NS = 36307976, O_MS = 36312072, O_END = 36312104;

constexpr size_t MiB = 1u << 20, KiB = 1024;
constexpr size_t WS_CTL = 0, CTL_ZERO_BYTES = 1 * MiB;
constexpr size_t WS_IG = 1 * MiB;
constexpr size_t WS_LF = 1 * MiB + 768 * KiB;
constexpr size_t WS_STAT1 = 2 * MiB + 512 * KiB;
constexpr size_t WS_C1P = 3 * MiB;
constexpr size_t WS_C2P = 3 * MiB + 256 * KiB;
constexpr size_t WS_C1 = 3 * MiB + 512 * KiB;
constexpr size_t WS_C2 = 3 * MiB + 528 * KiB;
constexpr size_t WS_SCNU = 3 * MiB + 768 * KiB;
constexpr size_t WS_STN = 3 * MiB + 896 * KiB;
constexpr size_t WS_SCML = 4 * MiB;
constexpr size_t WS_SCBS = 4 * MiB + 4 * KiB;
constexpr size_t WS_STM = 4 * MiB + 8 * KiB;
constexpr size_t WS_SCU = 5 * MiB;
constexpr size_t WS_STC = 21 * MiB;
constexpr size_t WS_WIN = 37 * MiB, WS_WOUT = 44 * MiB, WS_W1 = 46 * MiB, WS_W2 = 54 * MiB;
constexpr size_t WS_XB = 62 * MiB;
constexpr size_t WS_QA = 127 * MiB;
constexpr size_t WS_KA = WS_QA + 33 * MiB;
constexpr size_t WS_VA = WS_KA + 37 * MiB;
constexpr size_t WS_QB = WS_VA + 37 * MiB;
constexpr size_t WS_KB = WS_QB + 33 * MiB;
constexpr size_t WS_VB = WS_KB + 33 * MiB;
constexpr size_t WS_OG = WS_VB + 33 * MiB;
constexpr size_t WS_HID = 62 * MiB;
constexpr size_t WS_MIX = WS_OG + 33 * MiB;
constexpr size_t WS_Z1 = WS_MIX + 65 * MiB;
constexpr size_t WS_END = WS_Z1 + 65 * MiB;
static_assert(WS_HID + (size_t)MT * FF * 2 <= WS_OG, "HID overlay must not reach OG/MIX");
static_assert(WS_END <= 512 * MiB, "workspace map");
constexpr int CW_BAR = 4096;

constexpr int RING_BYTES = 131072;
constexpr int MISC_OFF = RING_BYTES + 320;
constexpr int LDS_BYTES = 147456;

#define GAS __attribute__((address_space(1)))
#define LAS __attribute__((address_space(3)))
typedef unsigned short bf16;
typedef unsigned v4u __attribute__((ext_vector_type(4)));
typedef unsigned v2u __attribute__((ext_vector_type(2)));
typedef float f32x4 __attribute__((ext_vector_type(4)));
typedef float f32x2 __attribute__((ext_vector_type(2)));
typedef float f32x16 __attribute__((ext_vector_type(16)));
typedef short bf16x8 __attribute__((ext_vector_type(8)));
typedef short s16x4 __attribute__((ext_vector_type(4)));
typedef GAS unsigned gu32;
#define RLX_AGENT __ATOMIC_RELAXED, __HIP_MEMORY_SCOPE_AGENT
#define LDS_WAIT() asm volatile("s_waitcnt lgkmcnt(0)" ::: "memory")
#define VM_WAIT() asm volatile("s_waitcnt vmcnt(0)" ::: "memory")

__device__ __forceinline__ unsigned f2bf(float f) { unsigned u = __builtin_bit_cast(unsigned, f); return (u + 0x7fffu + ((u >> 16) & 1u)) >> 16; }
__device__ __forceinline__ unsigned pk2(float lo, float hi) { return f2bf(lo) | (f2bf(hi) << 16); }
__device__ __forceinline__ float bflo(unsigned w) { return __builtin_bit_cast(float, w << 16); }
__device__ __forceinline__ float bfhi(unsigned w) { return __builtin_bit_cast(float, w & 0xffff0000u); }
__device__ __forceinline__ unsigned cvt_pk_bf16(float lo, float hi) { unsigned r; asm volatile("v_cvt_pk_bf16_f32 %0, %1, %2" : "=v"(r) : "v"(lo), "v"(hi)); return r; }
__device__ __forceinline__ float wave_sum(float v) {
#pragma unroll
    for (int o = 1; o < 64; o <<= 1) v += __shfl_xor(v, o);
    return v;
}
__device__ __forceinline__ int crow(int r, int hi) { return (r & 3) + 8 * (r >> 2) + 4 * hi; }
__device__ __forceinline__ float swap_max(float m) { auto rr = __builtin_amdgcn_permlane32_swap(__float_as_uint(m), __float_as_uint(m), false, false); return fmaxf(__uint_as_float(rr[0]), __uint_as_float(rr[1])); }
__device__ __forceinline__ float swap_add(float m) { auto rr = __builtin_amdgcn_permlane32_swap(__float_as_uint(m), __float_as_uint(m), false, false); return __uint_as_float(rr[0]) + __uint_as_float(rr[1]); }
typedef short v4i16_t __attribute__((ext_vector_type(4)));
__device__ __forceinline__ s16x4 trread(LAS const unsigned char* p) { return __builtin_bit_cast(s16x4, __builtin_amdgcn_ds_read_tr16_b64_v4i16((LAS v4i16_t*)p)); }
__device__ __forceinline__ bf16x8 trfrag(LAS const unsigned char* p) { const s16x4 lo = trread(p), hi = trread(p + 512); return (bf16x8){lo[0], lo[1], lo[2], lo[3], hi[0], hi[1], hi[2], hi[3]}; }

namespace pg8 {
#define PG8_LAS __attribute__((address_space(3)))
typedef unsigned short bf16_t;
typedef unsigned u32x4 __attribute__((ext_vector_type(4)));
constexpr int BM = 256, BK = 64, HALF = 128, HTB = HALF * BK * 2, STAGE_BYTES = 8 * HTB, NXCD = 8, WGM = 8;
__host__ __device__ __forceinline__ int lds_byte(int r, int c) { const int st = (r >> 4) * 2 + (c >> 5), rr = r & 15, cc = c & 31, ob = rr * 64 + cc * 2; return st * 1024 + (ob ^ (((ob >> 9) & 1) << 5)); }
__host__ __device__ __forceinline__ void stage_rc(int b, int& R, int& C) { const int st = b / 1024, sb = b % 1024, swz = sb ^ (((sb >> 9) & 1) << 5); R = (st >> 1) * 16 + swz / 64; C = (st & 1) * 32 + (swz % 64) / 2; }
__host__ __device__ __forceinline__ int perm32(int rho) { const int n = rho >> 4, i = rho & 15; return 8 * (i >> 2) + 4 * n + (i & 3); }
struct Unit { int pm, pn; };
struct Gemm { const bf16_t* A; const bf16_t* Bt; int M, N, K; };
struct StaticOrder {
    int nM, nN, nwg, G, c;
    __host__ __device__ void init(int M, int N, int G_, int c_) { nM = M / BM; nN = N / BM; nwg = nM * nN; G = G_; c = c_; }
    __host__ __device__ bool next(int i, Unit& u) const {
        const long L = (long)i * G + c; if (L >= nwg) return false;
        int wgid = (int)L; { const int q = nwg / NXCD, r = nwg % NXCD, xcd = wgid % NXCD, off = wgid / NXCD; wgid = (xcd < r ? xcd * (q + 1) : r * (q + 1) + (xcd - r) * q) + off; }
        const int nig = WGM * nN, gid = wgid / nig, fm = gid * WGM, gsz = (nM - fm) < WGM ? (nM - fm) : WGM;
        u.pm = fm + ((wgid % nig) % gsz); u.pn = (wgid % nig) / gsz; return true;
    }
    __device__ __forceinline__ void a_ready(const Unit&) const {}
    __device__ __forceinline__ void done(const Unit&) const {}
};

template <class Epi, class Sched, bool ALIGN_EPI = false, bool SP2 = false>
__device__ __forceinline__ void gemm_phase(PG8_LAS unsigned char* lds, const Gemm g, const Sched& S, const Epi& E) {
    const int tid = threadIdx.x, wid = __builtin_amdgcn_readfirstlane(tid >> 6), lane = tid & 63, wr = wid >> 2, wc = wid & 3, fr = lane & 15, fq = lane >> 4;
    const int K = g.K, nt = K / BK;
    unsigned voffA[2], voffB[2];
#pragma unroll
    for (int i = 0; i < 2; ++i) { int R, C; stage_rc(tid * 16 + i * 8192, R, C); const int Rb = Epi::PERM ? ((R & ~31) + perm32(R & 31)) : R;
        voffA[i] = (unsigned)(R * K + C) * 2u; voffB[i] = (unsigned)(Rb * K + C) * 2u; }
    const size_t kstep = (size_t)(BK * 2);
    const size_t hstep = (size_t)HALF * K * 2;
    const size_t tstep = 2 * hstep;
    const unsigned ldsw = (unsigned)wid * 1024u;
    const int aoff = lds_byte(wr * 64 + fr, fq * 8), boff = lds_byte(wc * 32 + fr, fq * 8);
#define PG8_SA(b, h) (((b) * 2 + (h)) * HTB)
#define PG8_SB(b, h) ((4 + (b) * 2 + (h)) * HTB)
#define PG8_STAGE(bufoff, gbase, voff) do { _Pragma("unroll") for (int _i = 0; _i < 2; ++_i) \
        __builtin_amdgcn_global_load_lds((const unsigned*)((const char*)(gbase) + (voff)[_i]), (PG8_LAS unsigned*)(lds + (bufoff) + ldsw + _i * 8192), 16, 0, 0); } while (0)
#define PG8_LDA(dst, b, h) do { _Pragma("unroll") for (int m = 0; m < 4; ++m) _Pragma("unroll") for (int k = 0; k < 2; ++k) dst[m][k] = *(const PG8_LAS bf16x8*)(lds + PG8_SA(b, h) + aoff + m * 2048 + k * 1024); } while (0)
#define PG8_LDB(dst, b, h) do { _Pragma("unroll") for (int n = 0; n < 2; ++n) _Pragma("unroll") for (int k = 0; k < 2; ++k) dst[n][k] = *(const PG8_LAS bf16x8*)(lds + PG8_SB(b, h) + boff + n * 2048 + k * 1024); } while (0)
#define PG8_MMA(ai, bj, At, Bt) do { __builtin_amdgcn_s_setprio(1); _Pragma("unroll") for (int m = 0; m < 4; ++m) _Pragma("unroll") for (int n = 0; n < 2; ++n) _Pragma("unroll") for (int k = 0; k < 2; ++k) \
        acc[ai][bj][m][n] = __builtin_amdgcn_mfma_f32_16x16x32_bf16(Bt[n][k], At[m][k], acc[ai][bj][m][n], 0, 0, 0); __builtin_amdgcn_s_setprio(0); } while (0)
#define PG8_WAIT_V(n) asm volatile("s_waitcnt vmcnt(" #n ")" ::: "memory")
#define PG8_WAIT_L(n) asm volatile("s_waitcnt lgkmcnt(" #n ")" ::: "memory")
#define PG8_BAR __builtin_amdgcn_s_barrier()
#define PG8_SCHED __builtin_amdgcn_sched_barrier(0)
    Unit cur, nxt; int ui = 0;
    if (!S.next(0, cur)) return;
    f32x4 acc[2][2][4][2];
#pragma unroll
    for (int a = 0; a < 2; ++a)
#pragma unroll
        for (int b = 0; b < 2; ++b)
#pragma unroll
            for (int m = 0; m < 4; ++m)
#pragma unroll
                for (int n = 0; n < 2; ++n) acc[a][b][m][n] = (f32x4){0.f, 0.f, 0.f, 0.f};
    bf16x8 At[4][2], B0[2][2], B1[2][2];
    const char* cA = (const char*)g.A + (size_t)cur.pm * tstep; const char* cB = (const char*)g.Bt + (size_t)cur.pn * tstep;
    S.a_ready(cur);
    if constexpr (SP2) {
        PG8_STAGE(PG8_SB(0, 0), cB, voffB); PG8_STAGE(PG8_SB(0, 1), cB + hstep, voffB); PG8_STAGE(PG8_SA(0, 0), cA, voffA); PG8_STAGE(PG8_SA(0, 1), cA + hstep, voffA);
        if (wr == 1) PG8_BAR;
        PG8_WAIT_V(2); PG8_BAR;
        PG8_STAGE(PG8_SB(1, 0), cB + kstep, voffB); PG8_STAGE(PG8_SA(1, 0), cA + kstep, voffA); PG8_STAGE(PG8_SB(1, 1), cB + hstep + kstep, voffB);
        PG8_WAIT_V(6); PG8_BAR;
    } else {
        PG8_STAGE(PG8_SB(0, 0), cB, voffB); PG8_STAGE(PG8_SA(0, 0), cA, voffA); PG8_STAGE(PG8_SB(0, 1), cB + hstep, voffB); PG8_STAGE(PG8_SA(0, 1), cA + hstep, voffA);
        if (wr == 1) PG8_BAR;
        PG8_WAIT_V(4); PG8_BAR;
        PG8_STAGE(PG8_SB(1, 0), cB + kstep, voffB); PG8_STAGE(PG8_SA(1, 0), cA + kstep, voffA); PG8_STAGE(PG8_SB(1, 1), cB + hstep + kstep, voffB);
        PG8_WAIT_V(6); PG8_BAR;
    }
    for (;;) {
        const bool has_next = S.next(ui + 1, nxt);
        const char* nA = has_next ? (const char*)g.A + (size_t)nxt.pm * tstep : cA; const char* nB = has_next ? (const char*)g.Bt + (size_t)nxt.pn * tstep : cB;
        for (int t = 0; t < nt; t += 2) {
            const bool last = (t == nt - 2);
            const char* a1 = cA + (size_t)(t + 1) * kstep;
            const char* a2 = last ? nA : cA + (size_t)(t + 2) * kstep; const char* b2 = last ? nB : cB + (size_t)(t + 2) * kstep;
            const char* a3 = a2 + kstep; const char* b3 = b2 + kstep;
            if (last && has_next) S.a_ready(nxt);
            if constexpr (SP2) {
            PG8_LDB(B0, 0, 0); PG8_LDB(B1, 0, 1); PG8_SCHED; PG8_LDA(At, 0, 0); PG8_STAGE(PG8_SA(1, 1), a1 + hstep, voffA);
            PG8_WAIT_V(8); PG8_WAIT_L(0); PG8_BAR; PG8_MMA(0, 0, At, B0); PG8_MMA(0, 1, At, B1); PG8_BAR; PG8_SCHED;
            PG8_LDA(At, 0, 1); PG8_STAGE(PG8_SB(0, 0), b2, voffB); PG8_STAGE(PG8_SB(0, 1), b2 + hstep, voffB); PG8_STAGE(PG8_SA(0, 0), a2, voffA);
            PG8_WAIT_V(8); PG8_WAIT_L(0); PG8_BAR; PG8_MMA(1, 0, At, B0); PG8_MMA(1, 1, At, B1); PG8_BAR; PG8_SCHED;
            PG8_LDB(B0, 1, 0); PG8_LDB(B1, 1, 1); PG8_SCHED; PG8_LDA(At, 1, 0); PG8_STAGE(PG8_SA(0, 1), a2 + hstep, voffA);
            PG8_WAIT_V(8); PG8_WAIT_L(0); PG8_BAR; PG8_MMA(0, 0, At, B0); PG8_MMA(0, 1, At, B1); PG8_BAR; PG8_SCHED;
            PG8_LDA(At, 1, 1); PG8_STAGE(PG8_SB(1, 0), b3, voffB); PG8_STAGE(PG8_SB(1, 1), b3 + hstep, voffB); PG8_STAGE(PG8_SA(1, 0), a3, voffA);
            PG8_WAIT_V(8); PG8_WAIT_L(0); PG8_BAR; PG8_MMA(1, 0, At, B0); PG8_MMA(1, 1, At, B1); PG8_BAR; PG8_SCHED;
            } else {
            PG8_LDB(B0, 0, 0); PG8_SCHED; PG8_LDA(At, 0, 0); PG8_STAGE(PG8_SA(1, 1), a1 + hstep, voffA);
            PG8_WAIT_L(8); PG8_BAR; PG8_WAIT_L(0); PG8_MMA(0, 0, At, B0); PG8_BAR; PG8_SCHED;
            PG8_LDB(B1, 0, 1); PG8_STAGE(PG8_SB(0, 0), b2, voffB);
            PG8_BAR; PG8_WAIT_L(0); PG8_MMA(0, 1, At, B1); PG8_BAR;
            PG8_LDA(At, 0, 1); PG8_STAGE(PG8_SA(0, 0), a2, voffA);
            PG8_BAR; PG8_WAIT_L(0); PG8_MMA(1, 0, At, B0); PG8_BAR; PG8_SCHED;
            PG8_STAGE(PG8_SB(0, 1), b2 + hstep, voffB);
            PG8_WAIT_V(6); PG8_BAR; PG8_MMA(1, 1, At, B1); PG8_BAR;
            PG8_LDB(B0, 1, 0); PG8_SCHED; PG8_LDA(At, 1, 0); PG8_STAGE(PG8_SA(0, 1), a2 + hstep, voffA);
            PG8_WAIT_L(8); PG8_BAR; PG8_WAIT_L(0); PG8_MMA(0, 0, At, B0); PG8_BAR; PG8_SCHED;
            PG8_LDB(B1, 1, 1); PG8_STAGE(PG8_SB(1, 0), b3, voffB);
            PG8_BAR; PG8_WAIT_L(0); PG8_MMA(0, 1, At, B1); PG8_BAR;
            PG8_LDA(At, 1, 1); PG8_STAGE(PG8_SA(1, 0), a3, voffA);
            PG8_BAR; PG8_WAIT_L(0); PG8_MMA(1, 0, At, B0); PG8_BAR; PG8_SCHED;
            PG8_STAGE(PG8_SB(1, 1), b3 + hstep, voffB);
            PG8_WAIT_V(6); PG8_BAR; PG8_MMA(1, 1, At, B1); PG8_BAR;
            }
        }
        if constexpr (ALIGN_EPI) { if (wr == 0) PG8_BAR; }
        E(acc, cur, wr, wc, fr, fq); S.done(cur);
        if (!has_next) break;
#pragma unroll
        for (int a = 0; a < 2; ++a)
#pragma unroll
            for (int b = 0; b < 2; ++b)
#pragma unroll
                for (int m = 0; m < 4; ++m)
#pragma unroll
                    for (int n = 0; n < 2; ++n) acc[a][b][m][n] = (f32x4){0.f, 0.f, 0.f, 0.f};
        cur = nxt; cA = nA; cB = nB; ++ui;
        if constexpr (ALIGN_EPI) { if (wr == 1) PG8_BAR; }
    }
    PG8_WAIT_V(0);
    if constexpr (!ALIGN_EPI) { if (wr == 0) PG8_BAR; }
    PG8_BAR;
#undef PG8_SA
#undef PG8_SB
#undef PG8_STAGE
#undef PG8_LDA
#undef PG8_LDB
#undef PG8_MMA
#undef PG8_WAIT_V
#undef PG8_WAIT_L
#undef PG8_BAR
#undef PG8_SCHED
}
}

struct EpiInProj {
    static constexpr bool PERM = true;
    unsigned char* ws; const float* bias; float* out;
    __device__ __forceinline__ void operator()(const f32x4 (&acc)[2][2][4][2], const pg8::Unit& u, int wr, int wc, int fr, int fq) const {
        const int colt = u.pn * 256, t = colt >> 9, cl = colt & 511;
        bf16* base = (bf16*)(ws + WS_QA + (size_t)t * (33 * MiB) + (t >= 2 ? 4 * MiB : 0) + (t >= 3 ? 4 * MiB : 0));
        const float sc = (t == 0) ? QSCALE : ((t == 4) ? KBSCALE : 1.f);
        const int row0 = u.pm * 256 + wr * 64 + fr, col0 = cl + wc * 32 + 8 * fq, bcol0 = colt + wc * 32 + 8 * fq;
        const bool kv = (t == 1 || t == 2);
        const bool ptail = kv && ((u.pm & 63) >= 62) && (u.pm < 128);
        const bool samp = (u.pm >= 128);
        const bool wf32 = kv && (samp || ptail);
        const size_t foff = (samp ? O_KS : O_KP) + ((t == 2) ? (samp ? (O_VS - O_KS) : (O_VP - O_KP)) : (size_t)0);
        float* of32 = out + foff;
        f32x4 bv[2][2];
#pragma unroll
        for (int bj = 0; bj < 2; ++bj)
#pragma unroll
            for (int n = 0; n < 2; ++n) bv[bj][n] = *(const f32x4*)(bias + bcol0 + bj * 128 + 4 * n);
#pragma unroll
        for (int ai = 0; ai < 2; ++ai)
#pragma unroll
            for (int m = 0; m < 4; ++m) {
                const int row = row0 + ai * 128 + m * 16;
                int orow = row;
                if (kv && samp) { const int s = row - MP; orow = MP + (s >> 6) * 576 + 512 + (s & 63); }
                long frow = 0;
                if (wf32) frow = samp ? (long)(row - MP) : (long)((row >> 14) * 512 + ((row & (SEQ - 1)) - (SEQ - 512)));
#pragma unroll
                for (int bj = 0; bj < 2; ++bj) {
                    f32x4 v0 = acc[ai][bj][m][0] + bv[bj][0], v1 = acc[ai][bj][m][1] + bv[bj][1];
                    if (wf32) { float* fp = of32 + frow * 512 + col0 + bj * 128; *(f32x4*)fp = v0; *(f32x4*)(fp + 4) = v1; }
                    if (t == 6) {
#pragma unroll
                        for (int e = 0; e < 4; ++e) { v0[e] = __builtin_amdgcn_rcpf(1.f + __expf(-v0[e])); v1[e] = __builtin_amdgcn_rcpf(1.f + __expf(-v1[e])); }
                    }
                    v0 = v0 * sc; v1 = v1 * sc;
                    v4u w; w.x = cvt_pk_bf16(v0[0], v0[1]); w.y = cvt_pk_bf16(v0[2], v0[3]); w.z = cvt_pk_bf16(v1[0], v1[1]); w.w = cvt_pk_bf16(v1[2], v1[3]);
                    *(v4u*)(base + (size_t)orow * AW + col0 + bj * 128) = w;
                }
            }
    }
};
struct EpiZ1 {
    static constexpr bool PERM = true;
    const float* xp; const float* xs; bf16* z1; float* stat;
    __device__ __forceinline__ void operator()(const f32x4 (&acc)[2][2][4][2], const pg8::Unit& u, int wr, int wc, int fr, int fq) const {
        const int row0 = u.pm * 256 + wr * 64 + fr, col0 = u.pn * 256 + wc * 32 + 8 * fq;
#pragma unroll
        for (int ai = 0; ai < 2; ++ai)
#pragma unroll
            for (int m = 0; m < 4; ++m) {
                const int row = row0 + ai * 128 + m * 16;
                const float* xr = (row < MP) ? xp + (size_t)row * DM : xs + (size_t)(row - MP) * DM;
                float s = 0.f, q = 0.f;
#pragma unroll
                for (int bj = 0; bj < 2; ++bj) {
                    const f32x4 x0 = *(const f32x4*)(xr + col0 + bj * 128), x1 = *(const f32x4*)(xr + col0 + bj * 128 + 4);
                    const f32x4 v0 = x0 * ALPHA + acc[ai][bj][m][0], v1 = x1 * ALPHA + acc[ai][bj][m][1];
                    s += (v0[0] + v0[1]) + (v0[2] + v0[3]) + (v1[0] + v1[1]) + (v1[2] + v1[3]);
                    q += (v0[0] * v0[0] + v0[1] * v0[1]) + (v0[2] * v0[2] + v0[3] * v0[3]) + (v1[0] * v1[0] + v1[1] * v1[1]) + (v1[2] * v1[2] + v1[3] * v1[3]);
                    v4u w; w.x = cvt_pk_bf16(v0[0], v0[1]); w.y = cvt_pk_bf16(v0[2], v0[3]); w.z = cvt_pk_bf16(v1[0], v1[1]); w.w = cvt_pk_bf16(v1[2], v1[3]);
                    *(v4u*)(z1 + (size_t)row * DM + col0 + bj * 128) = w;
                }
                s += __shfl_xor(s, 16); s += __shfl_xor(s, 32); q += __shfl_xor(q, 16); q += __shfl_xor(q, 32);
                if (fq == 0) { atomicAdd(stat + 2 * row, s); atomicAdd(stat + 2 * row + 1, q); }
            }
    }
};
struct EpiFfn1 {
    static constexpr bool PERM = true;
    const float* stat; const float* c1; const float* c2; bf16* hid;
    __device__ __forceinline__ void operator()(const f32x4 (&acc)[2][2][4][2], const pg8::Unit& u, int wr, int wc, int fr, int fq) const {
        const int row0 = u.pm * 256 + wr * 64 + fr, col0 = u.pn * 256 + wc * 32 + 8 * fq;
        f32x4 k1[2][2], k2[2][2];
#pragma unroll
        for (int bj = 0; bj < 2; ++bj)
#pragma unroll
            for (int n = 0; n < 2; ++n) { k1[bj][n] = *(const f32x4*)(c1 + col0 + bj * 128 + 4 * n); k2[bj][n] = *(const f32x4*)(c2 + col0 + bj * 128 + 4 * n); }
#pragma unroll
        for (int ai = 0; ai < 2; ++ai)
#pragma unroll
            for (int m = 0; m < 4; ++m) {
                const int row = row0 + ai * 128 + m * 16;
                const f32x2 st = *(const f32x2*)(stat + 2 * row);
                const float mean = st.x * (1.f / DM), var = fmaxf(st.y * (1.f / DM) - mean * mean, 0.f), rstd = 1.0f / sqrtf(var + LN_EPS);
#pragma unroll
                for (int bj = 0; bj < 2; ++bj) {
                    f32x4 v0 = (acc[ai][bj][m][0] - k1[bj][0] * mean) * rstd + k2[bj][0], v1 = (acc[ai][bj][m][1] - k1[bj][1] * mean) * rstd + k2[bj][1];
#pragma unroll
                    for (int e = 0; e < 4; ++e) { const float a = fmaxf(v0[e], 0.f), b = fmaxf(v1[e], 0.f); v0[e] = a * a; v1[e] = b * b; }
                    v4u w; w.x = cvt_pk_bf16(v0[0], v0[1]); w.y = cvt_pk_bf16(v0[2], v0[3]); w.z = cvt_pk_bf16(v1[0], v1[1]); w.w = cvt_pk_bf16(v1[2], v1[3]);
                    *(v4u*)(hid + (size_t)row * FF + col0 + bj * 128) = w;
                }
            }
    }
};
struct EpiFfn2 {
    static constexpr bool PERM = true;
    const float* stat; const bf16* z1; const float* g1; const float* b1; const float* bias; float* out;
    __device__ __forceinline__ void operator()(const f32x4 (&acc)[2][2][4][2], const pg8::Unit& u, int wr, int wc, int fr, int fq) const {
        const int row0 = u.pm * 256 + wr * 64 + fr, col0 = u.pn * 256 + wc * 32 + 8 * fq;
        f32x4 gg[2][2], bb[2][2], bo[2][2];
#pragma unroll
        for (int bj = 0; bj < 2; ++bj)
#pragma unroll
            for (int n = 0; n < 2; ++n) { gg[bj][n] = *(const f32x4*)(g1 + col0 + bj * 128 + 4 * n); bb[bj][n] = *(const f32x4*)(b1 + col0 + bj * 128 + 4 * n); bo[bj][n] = *(const f32x4*)(bias + col0 + bj * 128 + 4 * n); }
#pragma unroll
        for (int ai = 0; ai < 2; ++ai)
#pragma unroll
            for (int m = 0; m < 4; ++m) {
                const int row = row0 + ai * 128 + m * 16;
                const f32x2 st = *(const f32x2*)(stat + 2 * row);
                const float mean = st.x * (1.f / DM), var = fmaxf(st.y * (1.f / DM) - mean * mean, 0.f), rstd = 1.0f / sqrtf(var + LN_EPS);
#pragma unroll
                for (int bj = 0; bj < 2; ++bj) {
                    const v4u zz = *(const v4u*)(z1 + (size_t)row * DM + col0 + bj * 128);
                    const f32x4 z0 = (f32x4){bflo(zz.x), bfhi(zz.x), bflo(zz.y), bfhi(zz.y)}, z1v = (f32x4){bflo(zz.z), bfhi(zz.z), bflo(zz.w), bfhi(zz.w)};
                    const f32x4 h0 = (z0 - mean) * rstd * gg[bj][0] + bb[bj][0], h1 = (z1v - mean) * rstd * gg[bj][1] + bb[bj][1];
                    const f32x4 o0 = h0 * ALPHA + acc[ai][bj][m][0] + bo[bj][0], o1 = h1 * ALPHA + acc[ai][bj][m][1] + bo[bj][1];
                    float* op = out + (size_t)row * DM + col0 + bj * 128;
                    *(f32x4*)op = o0; *(f32x4*)(op + 4) = o1;
                }
            }
    }
};

struct Args { const float* in[20]; float* out; unsigned char* ws; int ph_lo, ph_hi, coop, pad; };
struct Frame {
    LAS unsigned char* lds;
    int tid, lane, wave, vcu, G;
    float* out; unsigned char* ws;
};

template <bool FOLD>
__device__ __forceinline__ void p0_transpose_item(const float* W, int K, int N, int ldw, bf16* WT, LAS float* scr, int item, int lane,
                                                  const float* g, const float* b, float* c1p, float* c2p) {
    const int nblk = N / 32, kb = item / nblk, nb = item % nblk, k0 = 64 * kb, n0 = 32 * nb;
#pragma unroll 8
    for (int i = 0; i < 32; ++i) { const int kk = 2 * i + (lane >> 5); scr[kk * 33 + (lane & 31)] = W[(size_t)(k0 + kk) * ldw + n0 + (lane & 31)]; }
    LDS_WAIT(); asm volatile("" ::: "memory");
    if constexpr (FOLD) {
        const int n = lane & 31, hf = lane >> 5; float s1 = 0.f, s2 = 0.f;
#pragma unroll 8
        for (int i = 0; i < 32; ++i) { const int kk = hf * 32 + i; const float w = scr[kk * 33 + n]; const float gw = w * g[k0 + kk];
            const float gr = __builtin_bit_cast(float, f2bf(gw) << 16); s1 += gr; s2 += w * b[k0 + kk]; scr[kk * 33 + n] = gw; }
        s1 += __shfl_xor(s1, 32); s2 += __shfl_xor(s2, 32);
        if (lane < 32) { c1p[(size_t)kb * N + n0 + n] = s1; c2p[(size_t)kb * N + n0 + n] = s2; }
        LDS_WAIT(); asm volatile("" ::: "memory");
    }
    const int c = lane & 7;
#pragma unroll
    for (int j = 0; j < 4; ++j) { const int n = (lane >> 3) + 8 * j; const LAS float* s = scr + (8 * c) * 33 + n;
        v4u o; o.x = pk2(s[0 * 33], s[1 * 33]); o.y = pk2(s[2 * 33], s[3 * 33]); o.z = pk2(s[4 * 33], s[5 * 33]); o.w = pk2(s[6 * 33], s[7 * 33]);
        *(GAS v4u*)(WT + (size_t)(n0 + n) * K + k0 + 8 * c) = o; }
    LDS_WAIT(); asm volatile("" ::: "memory");
}

__device__ __forceinline__ void p0_prologue(Frame& F, const Args& A) {
    const float* xp = A.in[0]; const float* xs = A.in[1]; const float* ck = A.in[2]; const float* cv = A.in[3];
    const float* w_in = A.in[7]; const float* b_in = A.in[8]; const float* w_out = A.in[11]; const float* ln1g = A.in[12]; const float* ln1b = A.in[13];
    const float* w1 = A.in[14]; const float* w2 = A.in[16];
    bf16* WIN = (bf16*)(F.ws + WS_WIN); bf16* WOUT = (bf16*)(F.ws + WS_WOUT); bf16* W1T = (bf16*)(F.ws + WS_W1); bf16* W2T = (bf16*)(F.ws + WS_W2);
    bf16* XB = (bf16*)(F.ws + WS_XB); bf16* KA = (bf16*)(F.ws + WS_KA); bf16* VA = (bf16*)(F.ws + WS_VA);
    float* IG = (float*)(F.ws + WS_IG); float* LFp = (float*)(F.ws + WS_LF); float* STAT = (float*)(F.ws + WS_STAT1);
    float* C1P = (float*)(F.ws + WS_C1P); float* C2P = (float*)(F.ws + WS_C2P);
    LAS float* scr = (LAS float*)(F.lds + F.wave * 8704);
    LAS float* wg = (LAS float*)(F.lds + 98304);
    const int gw = F.vcu * 8 + F.wave, NGW = F.G * 8;
    for (int k = F.tid; k < DM; k += 512) { const f32x4 a = *(const f32x4*)(w_in + (size_t)k * INW + NIN), b = *(const f32x4*)(w_in + (size_t)k * INW + NIN + 4);
        wg[0 * DM + k] = a[0]; wg[1 * DM + k] = a[1]; wg[2 * DM + k] = a[2]; wg[3 * DM + k] = a[3]; wg[4 * DM + k] = b[0]; wg[5 * DM + k] = b[1]; wg[6 * DM + k] = b[2]; wg[7 * DM + k] = b[3]; }
    for (int i = (int)blockIdx.x * 512 + F.tid; i < MT * 2; i += F.G * 512) STAT[i] = 0.f;
    __syncthreads();
    constexpr int I_IN = (DM / 64) * (NIN / 32), I_OUT = (DM / 64) * (DM / 32), I_1 = (DM / 64) * (FF / 32), I_2 = (FF / 64) * (DM / 32);
    constexpr int NITEMS = I_IN + I_OUT + I_1 + I_2;
    for (int it = gw; it < NITEMS; it += NGW) {
        int r = it;
        if (r < I_IN) { p0_transpose_item<false>(w_in, DM, NIN, INW, WIN, scr, r, F.lane, nullptr, nullptr, nullptr, nullptr); continue; } r -= I_IN;
        if (r < I_OUT) { p0_transpose_item<false>(w_out, DM, DM, DM, WOUT, scr, r, F.lane, nullptr, nullptr, nullptr, nullptr); continue; } r -= I_OUT;
        if (r < I_1) { p0_transpose_item<true>(w1, DM, FF, FF, W1T, scr, r, F.lane, ln1g, ln1b, C1P, C2P); continue; } r -= I_1;
        p0_transpose_item<false>(w2, FF, DM, DM, W2T, scr, r, F.lane, nullptr, nullptr, nullptr, nullptr);
    }
    for (int m = gw; m < MT; m += NGW) {
        const float* xrow = (m < MP) ? xp + (size_t)m * DM : xs + (size_t)(m - MP) * DM;
        const GAS f32x4* xr = (const GAS f32x4*)xrow + F.lane;
        f32x4 v[4]; float a[8];
#pragma unroll
        for (int g = 0; g < 8; ++g) a[g] = 0.f;
#pragma unroll
        for (int j = 0; j < 4; ++j) v[j] = xr[64 * j];
#pragma unroll
        for (int j = 0; j < 4; ++j)
#pragma unroll
            for (int g = 0; g < 8; ++g) { const f32x4 w = *(const LAS f32x4*)(wg + g * DM + 256 * j + 4 * F.lane); a[g] += (v[j][0] * w[0] + v[j][1] * w[1]) + (v[j][2] * w[2] + v[j][3] * w[3]); }
        GAS unsigned long long* o8 = (GAS unsigned long long*)(XB + (size_t)m * DM) + F.lane;
#pragma unroll
        for (int j = 0; j < 4; ++j) o8[64 * j] = (unsigned long long)pk2(v[j][0], v[j][1]) | ((unsigned long long)pk2(v[j][2], v[j][3]) << 32);
#pragma unroll
        for (int g = 0; g < 8; ++g) a[g] = wave_sum(a[g]);
        if (F.lane < 8) {
            float val = a[0];
#pragma unroll
            for (int g = 1; g < 8; ++g) val = (F.lane == g) ? a[g] : val;
            val += b_in[NIN + F.lane];
            if (F.lane < 4) IG[(size_t)m * 4 + F.lane] = val;
            else { const float ls = fminf(val, 0.f) - log1pf(__expf(-fabsf(val))); LFp[(size_t)m * 4 + F.lane - 4] = ls; }
        }
    }
    for (int it = gw; it < 2 * DB * 512; it += NGW) {
        const int which = it >= DB * 512, r = which ? it - DB * 512 : it, db = r >> 9, rr = r & 511;
        const float* src = (which ? cv : ck) + (size_t)r * AW + 8 * F.lane;
        const f32x4 a = *(const f32x4*)src, b = *(const f32x4*)(src + 4);
        v4u o; o.x = pk2(a[0], a[1]); o.y = pk2(a[2], a[3]); o.z = pk2(b[0], b[1]); o.w = pk2(b[2], b[3]);
        *(v4u*)((which ? VA : KA) + (size_t)(MP + db * 576 + rr) * AW + 8 * F.lane) = o;
    }
}

constexpr int AT_K = 0, AT_V = 16384, AT_BIAS = 32768, AT_WS = 34816, AT_OST = 36864;
__device__ __forceinline__ void attn_unit(Frame& F, const bf16* Q, const bf16* K, const bf16* V, bf16* MIX, const float* relb,
                                          int h, long qrow_base, long kv_base, int i_lo, int i_hi, int nactive) {
    const int tid = F.tid, lane = F.lane, r32 = lane & 31, hi = lane >> 5, wid = F.wave;
    const int wq = wid >> 1, wh = wid & 1;
    const bool active = wid < nactive;
    LAS unsigned char* lds = F.lds;
    LAS float* bias = (LAS float*)(lds + AT_BIAS);
    LAS float* wsf = (LAS float*)(lds + AT_WS) + wid * 64;
    if (tid < 257) bias[tid] = relb[h * 257 + tid] * LOG2E;
    const long qrow = qrow_base + 64 * wq + 32 * wh;
    bf16x8 qr[4];
#pragma unroll
    for (int d0 = 0; d0 < 4; ++d0) qr[d0] = (bf16x8){0, 0, 0, 0, 0, 0, 0, 0};
    if (active) {
#pragma unroll
        for (int d0 = 0; d0 < 4; ++d0) qr[d0] = *(const bf16x8*)(Q + (qrow + r32) * AW + h * 64 + d0 * 16 + hi * 8);
    }
    float m_run = -1e30f, l_run = 0.f;
    f32x16 o[2];
#pragma unroll
    for (int r = 0; r < 16; ++r) { o[0][r] = 0.f; o[1][r] = 0.f; }
    const unsigned ldsw = (unsigned)wid * 1024u;
#define AT_STAGE(i_, buf_) do { const long trow = kv_base + 64 * (long)(i_); \
        const bf16* ksrc = K + (trow + lane) * AW + h * 64 + wid * 8; \
        const bf16* vsrc = V + (trow + 16 * (wid & 3) + (lane >> 2)) * AW + h * 64 + (wid >> 2) * 32 + (lane & 3) * 8; \
        __builtin_amdgcn_global_load_lds((const unsigned*)ksrc, (LAS unsigned*)(lds + AT_K + (buf_) * 8192 + ldsw), 16, 0, 0); \
        __builtin_amdgcn_global_load_lds((const unsigned*)vsrc, (LAS unsigned*)(lds + AT_V + (buf_) * 8192 + ldsw), 16, 0, 0); } while (0)
    AT_STAGE(i_lo, 0);
    int cur = 0;
    for (int i = i_lo; i <= i_hi; ++i) {
        VM_WAIT(); __syncthreads();
        if (i + 1 <= i_hi) AT_STAGE(i + 1, cur ^ 1);
        if (active && i >= wq && i <= wq + 8) {
            const int delta = wq + 8 - i;
            const LAS unsigned char* kb = lds + AT_K + cur * 8192 + hi * 1024 + r32 * 16;
            const float cinit = (delta >= 3) ? bias[256] : 0.f;
            f32x16 p0, p1;
#pragma unroll
            for (int r = 0; r < 16; ++r) { p0[r] = cinit; p1[r] = cinit; }
#pragma unroll
            for (int d0 = 0; d0 < 4; ++d0) {
                const bf16x8 b0 = *(const LAS bf16x8*)(kb + d0 * 2048), b1 = *(const LAS bf16x8*)(kb + d0 * 2048 + 512);
                p0 = __builtin_amdgcn_mfma_f32_32x32x16_bf16(b0, qr[d0], p0, 0, 0, 0);
                p1 = __builtin_amdgcn_mfma_f32_32x32x16_bf16(b1, qr[d0], p1, 0, 0, 0);
            }
            if (delta <= 2) {
                const int bs = 64 * delta + 32 * wh + r32 + 128;
#pragma unroll
                for (int r = 0; r < 16; ++r) { const int kj = crow(r, hi); int i0 = bs - kj, i1 = bs - kj - 32; i0 = i0 > 256 ? 256 : i0; i1 = i1 > 256 ? 256 : i1; i0 = i0 < 0 ? 0 : i0; i1 = i1 < 0 ? 0 : i1;
                    p0[r] += bias[i0]; p1[r] += bias[i1]; }
            }
            float rm = fmaxf(p0[0], p1[0]);
#pragma unroll
            for (int r = 1; r < 16; ++r) rm = fmaxf(rm, fmaxf(p0[r], p1[r]));
            rm = swap_max(rm);
            if (__any(rm > m_run)) {
                const float mn = fmaxf(m_run, rm), f = __builtin_amdgcn_exp2f(m_run - mn);
                l_run *= f; m_run = mn;
                if (hi == 0) wsf[r32] = f;
                LDS_WAIT();
#pragma unroll
                for (int r = 0; r < 16; ++r) { const float fr_ = wsf[crow(r, hi)]; o[0][r] *= fr_; o[1][r] *= fr_; }
                LDS_WAIT();
            }
            float sacc = 0.f;
#pragma unroll
            for (int r = 0; r < 16; ++r) { p0[r] = __builtin_amdgcn_exp2f(p0[r] - m_run); p1[r] = __builtin_amdgcn_exp2f(p1[r] - m_run); sacc += p0[r] + p1[r]; }
            l_run += sacc;
            v4u pw[4];
            pw[0] = (v4u){cvt_pk_bf16(p0[0], p0[1]), cvt_pk_bf16(p0[2], p0[3]), cvt_pk_bf16(p0[4], p0[5]), cvt_pk_bf16(p0[6], p0[7])};
            pw[1] = (v4u){cvt_pk_bf16(p0[8], p0[9]), cvt_pk_bf16(p0[10], p0[11]), cvt_pk_bf16(p0[12], p0[13]), cvt_pk_bf16(p0[14], p0[15])};
            pw[2] = (v4u){cvt_pk_bf16(p1[0], p1[1]), cvt_pk_bf16(p1[2], p1[3]), cvt_pk_bf16(p1[4], p1[5]), cvt_pk_bf16(p1[6], p1[7])};
            pw[3] = (v4u){cvt_pk_bf16(p1[8], p1[9]), cvt_pk_bf16(p1[10], p1[11]), cvt_pk_bf16(p1[12], p1[13]), cvt_pk_bf16(p1[14], p1[15])};
            const LAS unsigned char* vb = lds + AT_V + cur * 8192 + ((lane >> 4) & 1) * 32 + (lane & 3) * 8 + (4 * hi + ((lane & 15) >> 2)) * 64;
#pragma unroll
            for (int d0 = 0; d0 < 2; ++d0)
#pragma unroll
                for (int ks = 0; ks < 4; ++ks) {
                    const bf16x8 vf = trfrag(vb + d0 * 4096 + ks * 1024);
                    o[d0] = __builtin_amdgcn_mfma_f32_32x32x16_bf16(__builtin_bit_cast(bf16x8, pw[ks]), vf, o[d0], 0, 0, 0);
                }
        }
        cur ^= 1;
    }
    if (active) {
        const float lt = swap_add(l_run);
        if (hi == 0) wsf[32 + r32] = lt;
        LDS_WAIT();
        LAS bf16* stg = (LAS bf16*)(lds + AT_OST) + wid * 2048;
#pragma unroll
        for (int r = 0; r < 16; ++r) { const int orow = crow(r, hi); const float rl = __builtin_amdgcn_rcpf(wsf[32 + orow]);
            stg[orow * 64 + r32] = (bf16)f2bf(o[0][r] * rl); stg[orow * 64 + 32 + r32] = (bf16)f2bf(o[1][r] * rl); }
        LDS_WAIT();
#pragma unroll
        for (int i = 0; i < 4; ++i) { const int row = i * 8 + (lane >> 3), ch = lane & 7; const v4u v = *(const LAS v4u*)(stg + row * 64 + ch * 8);
            *(v4u*)(MIX + (qrow + row) * DM + h * 64 + ch * 8) = v; }
    }
    LDS_WAIT();
    __syncthreads();
#undef AT_STAGE
}

__device__ __forceinline__ int tr_off(int s, int c16) { return (c16 >> 2) * 4096 + (s >> 4) * 1024 + (s & 15) * 64 + (c16 & 3) * 16; }
__device__ __forceinline__ int tr_read_base(int lane) { const int hi = lane >> 5; return ((lane >> 4) & 1) * 32 + (lane & 3) * 8 + (4 * hi + ((lane & 15) >> 2)) * 64; }
__device__ __forceinline__ v4u scale8(v4u k, float w) {
    v4u o; o.x = pk2(bflo(k.x) * w, bfhi(k.x) * w); o.y = pk2(bflo(k.y) * w, bfhi(k.y) * w); o.z = pk2(bflo(k.z) * w, bfhi(k.z) * w); o.w = pk2(bflo(k.w) * w, bfhi(k.w) * w); return o;
}

__device__ __forceinline__ void mlstm_stage1_item(Frame& F, int item) {
    const int tid = F.tid, lane = F.lane, wid = F.wave, r32 = lane & 31, hi = lane >> 5;
    const int seq = item >> 5, j = item & 31, b = seq >> 2, h = seq & 3;
    const long row0 = (long)b * SEQ + (long)j * 512;
    const bf16* KB = (const bf16*)(F.ws + WS_KB); const bf16* VB = (const bf16*)(F.ws + WS_VB);
    const float* IG = (const float*)(F.ws + WS_IG); const float* LFp = (const float*)(F.ws + WS_LF);
    LAS unsigned char* lds = F.lds;
    LAS float* wts = (LAS float*)(lds + 32768); LAS float* red = (LAS float*)(lds + 34816);
    const float lfv = LFp[(row0 + tid) * 4 + h], igv = IG[(row0 + tid) * 4 + h];
    float bs = lfv;
#pragma unroll
    for (int off = 1; off < 64; off <<= 1) { const float t = __shfl_up(bs, off); if (lane >= off) bs += t; }
    if (lane == 63) red[wid] = bs;
    __syncthreads();
    float woff = 0.f, btot = 0.f;
#pragma unroll
    for (int w = 0; w < 8; ++w) { const float t = red[w]; if (w < wid) woff += t; btot += t; }
    bs += woff;
    const float e = btot - bs + igv;
    float mx = e;
#pragma unroll
    for (int o = 1; o < 64; o <<= 1) mx = fmaxf(mx, __shfl_xor(mx, o));
    if (lane == 0) red[16 + wid] = mx;
    __syncthreads();
    float mloc = red[16];
#pragma unroll
    for (int w = 1; w < 8; ++w) mloc = fmaxf(mloc, red[16 + w]);
    wts[tid] = __expf(e - mloc);
    __syncthreads();
    f32x16 acc[2];
#pragma unroll
    for (int r = 0; r < 16; ++r) { acc[0][r] = 0.f; acc[1][r] = 0.f; }
    float nsum = 0.f;
    const int kb = wid >> 1, vb0 = 2 * (wid & 1);
    const int trb = tr_read_base(lane);
    for (int c = 0; c < 8; ++c) {
        v4u kv[2], vv[2];
#pragma unroll
        for (int i = 0; i < 2; ++i) { const int p = tid + 512 * i, row = p >> 4, c16 = p & 15;
            kv[i] = *(const v4u*)(KB + (row0 + c * 64 + row) * AW + h * 128 + c16 * 8); vv[i] = *(const v4u*)(VB + (row0 + c * 64 + row) * AW + h * 128 + c16 * 8); }
#pragma unroll
        for (int i = 0; i < 2; ++i) { const int p = tid + 512 * i, row = p >> 4, c16 = p & 15;
            *(LAS v4u*)(lds + tr_off(row, c16)) = scale8(kv[i], wts[c * 64 + row]); *(LAS v4u*)(lds + 16384 + tr_off(row, c16)) = vv[i]; }
        __syncthreads();
#pragma unroll
        for (int ks = 0; ks < 4; ++ks) {
            const bf16x8 af = trfrag(lds + kb * 4096 + ks * 1024 + trb);
#pragma unroll
            for (int vi = 0; vi < 2; ++vi) { const bf16x8 bfr = trfrag(lds + 16384 + (vb0 + vi) * 4096 + ks * 1024 + trb);
                acc[vi] = __builtin_amdgcn_mfma_f32_32x32x16_bf16(af, bfr, acc[vi], 0, 0, 0); }
        }
        if (tid < 128) {
            const int k = tid; float s = 0.f;
#pragma unroll 8
            for (int sidx = 0; sidx < 64; ++sidx) { const unsigned short w = *(const LAS unsigned short*)(lds + (k >> 5) * 4096 + (sidx >> 4) * 1024 + (sidx & 15) * 64 + (k & 31) * 2); s += __builtin_bit_cast(float, (unsigned)w << 16); }
            nsum += s;
        }
        __syncthreads();
    }
    float* U = (float*)(F.ws + WS_SCU) + (size_t)item * 16384;
#pragma unroll
    for (int vi = 0; vi < 2; ++vi) { const int v = 32 * (vb0 + vi) + r32;
#pragma unroll
        for (int g4 = 0; g4 < 4; ++g4) *(f32x4*)(U + v * 128 + 32 * kb + 8 * g4 + 4 * hi) = (f32x4){acc[vi][4 * g4], acc[vi][4 * g4 + 1], acc[vi][4 * g4 + 2], acc[vi][4 * g4 + 3]}; }
    if (tid < 128) ((float*)(F.ws + WS_SCNU))[item * 128 + tid] = nsum;
    if (tid == 0) { ((float*)(F.ws + WS_SCML))[item] = mloc; ((float*)(F.ws + WS_SCBS))[item] = btot; }
    __syncthreads();
}

__device__ __forceinline__ void p3_scan(Frame& F, const float* bff1) {
    const int gid = F.vcu * 512 + F.tid, NT = F.G * 512;
    const float* U = (const float*)(F.ws + WS_SCU); const float* NU = (const float*)(F.ws + WS_SCNU);
    const float* ML = (const float*)(F.ws + WS_SCML); const float* BS = (const float*)(F.ws + WS_SCBS);
    float* STC = (float*)(F.ws + WS_STC); float* STN = (float*)(F.ws + WS_STN); float* STM = (float*)(F.ws + WS_STM);
    for (int e = gid; e < 8 * 16384 + 8 * 128; e += NT) {
        const bool isn = e >= 8 * 16384; const int ee = isn ? e - 8 * 16384 : e;
        const int seq = isn ? (ee >> 7) : (ee >> 14), el = isn ? (ee & 127) : (ee & 16383);
        float u[31];
#pragma unroll
        for (int j = 0; j < 31; ++j) u[j] = isn ? NU[(seq * 32 + j) * 128 + el] : U[(size_t)(seq * 32 + j) * 16384 + el];
        float c = 0.f, m = 0.f;
#pragma unroll
        for (int j = 0; j < 32; ++j) {
            if (isn) STN[(seq * 32 + j) * 128 + el] = c; else STC[(size_t)(seq * 32 + j) * 16384 + el] = c;
            if (el == 0 && !isn) STM[seq * 32 + j] = m;
            if (j < 31) { const float bsj = BS[seq * 32 + j], mlj = ML[seq * 32 + j]; const float mn = fmaxf(bsj + m, mlj);
                c = __expf(bsj + m - mn) * c + __expf(mlj - mn) * u[j]; m = mn; }
        }
    }
    const float* C1P = (const float*)(F.ws + WS_C1P); const float* C2P = (const float*)(F.ws + WS_C2P);
    float* C1 = (float*)(F.ws + WS_C1); float* C2 = (float*)(F.ws + WS_C2);
    for (int n = gid; n < FF; n += NT) { float s1 = 0.f, s2 = 0.f;
#pragma unroll
        for (int kb = 0; kb < 16; ++kb) { s1 += C1P[kb * FF + n]; s2 += C2P[kb * FF + n]; }
        C1[n] = s1; C2[n] = s2 + bff1[n]; }
}

constexpr int M3_Q = 0, M3_K = 16384, M3_V = 32768, M3_KW = 49152, M3_C = 65536, M3_S = 98304, M3_H = 0;
__device__ __forceinline__ void mlstm_stage3_item(Frame& F, const Args& A, int item) {
    const int tid = F.tid, lane = F.lane, wid = F.wave, r32 = lane & 31, hi = lane >> 5;
    const bf16* QB = (const bf16*)(F.ws + WS_QB); const bf16* KB = (const bf16*)(F.ws + WS_KB); const bf16* VB = (const bf16*)(F.ws + WS_VB); const bf16* OG = (const bf16*)(F.ws + WS_OG);
    const float* IG = (const float*)(F.ws + WS_IG); const float* LFp = (const float*)(F.ws + WS_LF);
    bf16* MIX = (bf16*)(F.ws + WS_MIX);
    const float* gn = A.in[10];
    int h, nch; long row0; const float* C0; const float* N0; float m0; bool zero_init = false;
    float* Cout; float* Nout; float* Mout; bool last;
    if (item < 256) {
        const int seq = item >> 5, j = item & 31, b = seq >> 2; h = seq & 3; row0 = (long)b * SEQ + (long)j * 512; nch = 8;
        C0 = (const float*)(F.ws + WS_STC) + (size_t)item * 16384; N0 = (const float*)(F.ws + WS_STN) + item * 128; m0 = ((const float*)(F.ws + WS_STM))[item];
        zero_init = (j == 0); last = (j == 31);
        Cout = F.out + O_CP + (size_t)seq * 16384; Nout = F.out + O_NP + seq * 128; Mout = F.out + O_MP + seq;
    } else {
        const int s = item - 256, db = s >> 2; h = s & 3; row0 = MP + (long)db * 64; nch = 1;
        C0 = A.in[4] + (size_t)s * 16384; N0 = A.in[5] + s * 128; m0 = A.in[6][s]; last = true;
        Cout = F.out + O_CS + (size_t)s * 16384; Nout = F.out + O_NS + s * 128; Mout = F.out + O_MS + s;
    }
    LAS unsigned char* lds = F.lds;
    LAS float* sa = (LAS float*)(lds + M3_S);
    LAS float* smu = sa + 64; LAS float* sg = sa + 128; LAS float* swe = sa + 192; LAS float* senm = sa + 256;
    LAS float* srs = sa + 320; LAS float* snq = sa + 384; LAS float* sinv = sa + 448; LAS float* sn = sa + 512;
    LAS float* sdec = sa + 640;
    const int kb = wid >> 1, vb0 = 2 * (wid & 1);
    const int th = wid >> 2, vq = wid & 3;
    const int trb = tr_read_base(lane);
    f32x16 cacc[2];
#pragma unroll
    for (int vi = 0; vi < 2; ++vi) { const int v = 32 * (vb0 + vi) + r32;
#pragma unroll
        for (int g4 = 0; g4 < 4; ++g4) { f32x4 x = (f32x4){0.f, 0.f, 0.f, 0.f}; if (!zero_init) x = *(const f32x4*)(C0 + v * 128 + 32 * kb + 8 * g4 + 4 * hi);
            cacc[vi][4 * g4] = x[0]; cacc[vi][4 * g4 + 1] = x[1]; cacc[vi][4 * g4 + 2] = x[2]; cacc[vi][4 * g4 + 3] = x[3];
            *(LAS v2u*)(lds + M3_C + (4 * kb + g4) * 2048 + v * 16 + hi * 8) = (v2u){pk2(x[0], x[1]), pk2(x[2], x[3])}; } }
    if (tid < 128) sn[tid] = zero_init ? 0.f : N0[tid];
    float mrun = zero_init ? 0.f : m0;
    __syncthreads();
    for (int c = 0; c < nch; ++c) {
        const long rowc = row0 + c * 64;
        v4u qv[2], kv[2], vv[2];
#pragma unroll
        for (int i = 0; i < 2; ++i) { const int p = tid + 512 * i, row = p >> 4, c16 = p & 15; const size_t off = (size_t)(rowc + row) * AW + h * 128 + c16 * 8;
            qv[i] = *(const v4u*)(QB + off); kv[i] = *(const v4u*)(KB + off); vv[i] = *(const v4u*)(VB + off); }
        if (wid == 0) {
            const float lfv = LFp[(rowc + lane) * 4 + h], igv = IG[(rowc + lane) * 4 + h];
            float bs = lfv;
#pragma unroll
            for (int off = 1; off < 64; off <<= 1) { const float t = __shfl_up(bs, off); if (lane >= off) bs += t; }
            const float a = igv - bs;
            float pm = a;
#pragma unroll
            for (int off = 1; off < 64; off <<= 1) { const float t = __shfl_up(pm, off); if (lane >= off) pm = fmaxf(pm, t); }
            const float mu = fmaxf(mrun, pm), g = __expf(mrun - mu);
            const float muL = __shfl(mu, 63), bL = __shfl(bs, 63);
            sa[lane] = a; smu[lane] = mu; sg[lane] = g; swe[lane] = __expf(a - muL); senm[lane] = __expf(-(bs + mu));
            if (lane == 0) sdec[0] = __expf(mrun - muL);
            mrun = bL + muL;
        }
#pragma unroll
        for (int i = 0; i < 2; ++i) { const int p = tid + 512 * i, row = p >> 4, c16 = p & 15;
            *(LAS v4u*)(lds + M3_Q + c16 * 1024 + row * 16) = qv[i]; *(LAS v4u*)(lds + M3_K + c16 * 1024 + row * 16) = kv[i]; *(LAS v4u*)(lds + M3_V + tr_off(row, c16)) = vv[i]; }
        __syncthreads();
#pragma unroll
        for (int i = 0; i < 2; ++i) { const int p = tid + 512 * i, row = p >> 4, c16 = p & 15; *(LAS v4u*)(lds + M3_KW + tr_off(row, c16)) = scale8(kv[i], swe[row]); }
        { const int t = tid >> 3, part = tid & 7; float s = 0.f;
#pragma unroll
          for (int cc = 0; cc < 2; ++cc) { const int ch = 2 * part + cc; const v4u q8 = *(const LAS v4u*)(lds + M3_Q + ch * 1024 + t * 16);
              const f32x4 n0 = *(const LAS f32x4*)(sn + ch * 8), n1 = *(const LAS f32x4*)(sn + ch * 8 + 4);
              s += bflo(q8.x) * n0[0] + bfhi(q8.x) * n0[1] + bflo(q8.y) * n0[2] + bfhi(q8.y) * n0[3] + bflo(q8.z) * n1[0] + bfhi(q8.z) * n1[1] + bflo(q8.w) * n1[2] + bfhi(q8.w) * n1[3]; }
          s += __shfl_xor(s, 1); s += __shfl_xor(s, 2); s += __shfl_xor(s, 4);
          if (part == 0) snq[t] = s; }
        bf16x8 qf[8];
#pragma unroll
        for (int d0 = 0; d0 < 8; ++d0) qf[d0] = *(const LAS bf16x8*)(lds + M3_Q + (2 * d0 + hi) * 1024 + (32 * th + r32) * 16);
        v4u pw[4]; float rs = 0.f;
        const int tt = 32 * th + r32; const float mut = smu[tt];
#pragma unroll
        for (int sh = 0; sh < 2; ++sh) {
            f32x16 p;
#pragma unroll
            for (int r = 0; r < 16; ++r) p[r] = 0.f;
#pragma unroll
            for (int d0 = 0; d0 < 8; ++d0) { const bf16x8 kf = *(const LAS bf16x8*)(lds + M3_K + (2 * d0 + hi) * 1024 + (32 * sh + r32) * 16);
                p = __builtin_amdgcn_mfma_f32_32x32x16_bf16(kf, qf[d0], p, 0, 0, 0); }
#pragma unroll
            for (int g4 = 0; g4 < 4; ++g4) { const f32x4 av = *(const LAS f32x4*)(sa + 32 * sh + 8 * g4 + 4 * hi);
#pragma unroll
                for (int e = 0; e < 4; ++e) { const int s = 32 * sh + 8 * g4 + 4 * hi + e; const float w = (s <= tt) ? __expf(av[e] - mut) : 0.f; const float x = p[4 * g4 + e] * w; p[4 * g4 + e] = x; rs += x; } }
            pw[2 * sh] = (v4u){cvt_pk_bf16(p[0], p[1]), cvt_pk_bf16(p[2], p[3]), cvt_pk_bf16(p[4], p[5]), cvt_pk_bf16(p[6], p[7])};
            pw[2 * sh + 1] = (v4u){cvt_pk_bf16(p[8], p[9]), cvt_pk_bf16(p[10], p[11]), cvt_pk_bf16(p[12], p[13]), cvt_pk_bf16(p[14], p[15])};
        }
        rs = swap_add(rs);
        if (vq == 0 && hi == 0) srs[tt] = rs;
        f32x16 num;
#pragma unroll
        for (int r = 0; r < 16; ++r) num[r] = 0.f;
#pragma unroll
        for (int d0 = 0; d0 < 8; ++d0) { const bf16x8 cf = *(const LAS bf16x8*)(lds + M3_C + (2 * d0 + hi) * 2048 + (32 * vq + r32) * 16);
            num = __builtin_amdgcn_mfma_f32_32x32x16_bf16(qf[d0], cf, num, 0, 0, 0); }
#pragma unroll
        for (int g4 = 0; g4 < 4; ++g4) { const f32x4 gv = *(const LAS f32x4*)(sg + 32 * th + 8 * g4 + 4 * hi);
#pragma unroll
            for (int e = 0; e < 4; ++e) num[4 * g4 + e] *= gv[e]; }
#pragma unroll
        for (int ks = 0; ks < 4; ++ks) { const bf16x8 vf = trfrag(lds + M3_V + vq * 4096 + ks * 1024 + trb);
            num = __builtin_amdgcn_mfma_f32_32x32x16_bf16(__builtin_bit_cast(bf16x8, pw[ks]), vf, num, 0, 0, 0); }
        __syncthreads();
        if (tid < 64) { const float den = sg[tid] * snq[tid] + srs[tid]; sinv[tid] = 1.0f / fmaxf(fabsf(den), senm[tid]); }
        const float decay = sdec[0];
#pragma unroll
        for (int vi = 0; vi < 2; ++vi)
#pragma unroll
            for (int r = 0; r < 16; ++r) cacc[vi][r] *= decay;
#pragma unroll
        for (int ks = 0; ks < 4; ++ks) { const bf16x8 af = trfrag(lds + M3_KW + kb * 4096 + ks * 1024 + trb);
#pragma unroll
            for (int vi = 0; vi < 2; ++vi) { const bf16x8 bfr = trfrag(lds + M3_V + (vb0 + vi) * 4096 + ks * 1024 + trb);
                cacc[vi] = __builtin_amdgcn_mfma_f32_32x32x16_bf16(af, bfr, cacc[vi], 0, 0, 0); } }
        if (tid < 128) { const int k = tid; float s = 0.f;
#pragma unroll 8
            for (int sidx = 0; sidx < 64; ++sidx) { const unsigned short w = *(const LAS unsigned short*)(lds + M3_KW + (k >> 5) * 4096 + (sidx >> 4) * 1024 + (sidx & 15) * 64 + (k & 31) * 2); s += __builtin_bit_cast(float, (unsigned)w << 16); }
            sn[k] = decay * sn[k] + s; }
        __syncthreads();
#pragma unroll
        for (int g4 = 0; g4 < 4; ++g4) { const f32x4 iv = *(const LAS f32x4*)(sinv + 32 * th + 8 * g4 + 4 * hi);
#pragma unroll
            for (int e = 0; e < 4; ++e) { const int t = 32 * th + 8 * g4 + 4 * hi + e; *(LAS float*)(lds + M3_H + (t * 128 + 32 * vq + r32) * 4) = num[4 * g4 + e] * iv[e]; } }
#pragma unroll
        for (int vi = 0; vi < 2; ++vi) { const int v = 32 * (vb0 + vi) + r32;
#pragma unroll
            for (int g4 = 0; g4 < 4; ++g4) *(LAS v2u*)(lds + M3_C + (4 * kb + g4) * 2048 + v * 16 + hi * 8) = (v2u){pk2(cacc[vi][4 * g4], cacc[vi][4 * g4 + 1]), pk2(cacc[vi][4 * g4 + 2], cacc[vi][4 * g4 + 3])}; }
        __syncthreads();
        { const int t = tid >> 3, part = tid & 7; f32x4 x[4]; float s = 0.f;
#pragma unroll
          for (int i = 0; i < 4; ++i) { x[i] = *(const LAS f32x4*)(lds + M3_H + (t * 128 + part * 16 + 4 * i) * 4); s += (x[i][0] + x[i][1]) + (x[i][2] + x[i][3]); }
          s += __shfl_xor(s, 1); s += __shfl_xor(s, 2); s += __shfl_xor(s, 4);
          const float mean = s * (1.f / 128.f); float q = 0.f;
#pragma unroll
          for (int i = 0; i < 4; ++i) { x[i] = x[i] - mean; q += (x[i][0] * x[i][0] + x[i][1] * x[i][1]) + (x[i][2] * x[i][2] + x[i][3] * x[i][3]); }
          q += __shfl_xor(q, 1); q += __shfl_xor(q, 2); q += __shfl_xor(q, 4);
          const float rstd = 1.0f / sqrtf(q * (1.f / 128.f) + LN_EPS);
          const size_t orow = (size_t)(rowc + t);
          const v4u og0 = *(const v4u*)(OG + orow * AW + h * 128 + part * 16), og1 = *(const v4u*)(OG + orow * AW + h * 128 + part * 16 + 8);
          const float* gp = gn + h * 128 + part * 16;
          const f32x4 g0 = *(const f32x4*)gp, g1 = *(const f32x4*)(gp + 4), g2 = *(const f32x4*)(gp + 8), g3 = *(const f32x4*)(gp + 12);
          v4u o0, o1;
          o0.x = pk2(x[0][0] * rstd * g0[0] * bflo(og0.x), x[0][1] * rstd * g0[1] * bfhi(og0.x)); o0.y = pk2(x[0][2] * rstd * g0[2] * bflo(og0.y), x[0][3] * rstd * g0[3] * bfhi(og0.y));
          o0.z = pk2(x[1][0] * rstd * g1[0] * bflo(og0.z), x[1][1] * rstd * g1[1] * bfhi(og0.z)); o0.w = pk2(x[1][2] * rstd * g1[2] * bflo(og0.w), x[1][3] * rstd * g1[3] * bfhi(og0.w));
          o1.x = pk2(x[2][0] * rstd * g2[0] * bflo(og1.x), x[2][1] * rstd * g2[1] * bfhi(og1.x)); o1.y = pk2(x[2][2] * rstd * g2[2] * bflo(og1.y), x[2][3] * rstd * g2[3] * bfhi(og1.y));
          o1.z = pk2(x[3][0] * rstd * g3[0] * bflo(og1.z), x[3][1] * rstd * g3[1] * bfhi(og1.z)); o1.w = pk2(x[3][2] * rstd * g3[2] * bflo(og1.w), x[3][3] * rstd * g3[3] * bfhi(og1.w));
          bf16* mp = MIX + orow * DM + 512 + h * 128 + part * 16;
          *(v4u*)mp = o0; *(v4u*)(mp + 8) = o1; }
        __syncthreads();
    }
    if (last) {
#pragma unroll
        for (int vi = 0; vi < 2; ++vi) { const int v = 32 * (vb0 + vi) + r32;
#pragma unroll
            for (int g4 = 0; g4 < 4; ++g4) *(f32x4*)(Cout + v * 128 + 32 * kb + 8 * g4 + 4 * hi) = (f32x4){cacc[vi][4 * g4], cacc[vi][4 * g4 + 1], cacc[vi][4 * g4 + 2], cacc[vi][4 * g4 + 3]}; }
        if (tid < 128) Nout[tid] = sn[tid];
        if (tid == 0) Mout[0] = mrun;
    }
    __syncthreads();
}

__device__ __forceinline__ void p8_final_ln(Frame& F, const float* g2, const float* b2) {
    const int gw = F.vcu * 8 + F.wave, NGW = F.G * 8;
    f32x4 gg[4], bb[4];
#pragma unroll
    for (int j = 0; j < 4; ++j) { gg[j] = *(const f32x4*)(g2 + 256 * j + 4 * F.lane); bb[j] = *(const f32x4*)(b2 + 256 * j + 4 * F.lane); }
    for (int m = gw; m < MT; m += NGW) {
        GAS f32x4* xr = (GAS f32x4*)(F.out + (size_t)m * DM) + F.lane;
        f32x4 v[4]; float s = 0.f;
#pragma unroll
        for (int j = 0; j < 4; ++j) { v[j] = xr[64 * j]; s += (v[j][0] + v[j][1]) + (v[j][2] + v[j][3]); }
        const float mean = wave_sum(s) * (1.f / DM); float s2 = 0.f;
#pragma unroll
        for (int j = 0; j < 4; ++j) { v[j] = v[j] - mean; s2 += (v[j][0] * v[j][0] + v[j][1] * v[j][1]) + (v[j][2] * v[j][2] + v[j][3] * v[j][3]); }
        const float rstd = 1.f / sqrtf(wave_sum(s2) * (1.f / DM) + LN_EPS);
#pragma unroll
        for (int j = 0; j < 4; ++j) xr[64 * j] = v[j] * rstd * gg[j] + bb[j];
    }
}

constexpr int N_PHASES = 9;

__global__ void __launch_bounds__(512, 2) hybrid_fwd(Args args) {
    extern __shared__ __attribute__((aligned(16))) unsigned char lds_raw[];
    Frame F;
    F.lds = (LAS unsigned char*)lds_raw;
    F.tid = threadIdx.x; F.lane = F.tid & 63; F.wave = __builtin_amdgcn_readfirstlane(F.tid >> 6);
    F.G = gridDim.x; { const int bx = blockIdx.x; F.vcu = (F.G % 8 == 0) ? (bx % 8) * (F.G / 8) + bx / 8 : bx; }
    F.out = args.out; F.ws = args.ws;
    const int lo = args.ph_lo, hi = args.ph_hi;
#define IN(k) (lo <= (k) && (k) < hi)
#define BOTH(k) (IN(k) && IN((k) + 1))
#define GRID_BAR() do { __syncthreads(); cg::this_grid().sync(); } while (0)

    if (IN(0)) { p0_prologue(F, args); if (BOTH(0)) GRID_BAR(); }

    if (IN(1)) {
        pg8::Gemm g{(const bf16*)(F.ws + WS_XB), (const bf16*)(F.ws + WS_WIN), MT, NIN, DM}; pg8::StaticOrder S; S.init(MT, NIN, F.G, (int)blockIdx.x);
        EpiInProj E; E.ws = F.ws; E.bias = args.in[8];
        static_assert(WS_KA == WS_QA + 33 * MiB && WS_VA == WS_QA + 70 * MiB && WS_QB == WS_QA + 107 * MiB && WS_KB == WS_QA + 140 * MiB && WS_VB == WS_QA + 173 * MiB && WS_OG == WS_QA + 206 * MiB, "slice map");
        E.out = F.out;
        pg8::gemm_phase<EpiInProj, pg8::StaticOrder, true, true>(F.lds, g, S, E);
        if (BOTH(1)) GRID_BAR();
    }

    if (IN(2)) {
        const bf16* QA = (const bf16*)(F.ws + WS_QA); const bf16* KA = (const bf16*)(F.ws + WS_KA); const bf16* VA = (const bf16*)(F.ws + WS_VA); bf16* MIX = (bf16*)(F.ws + WS_MIX);
        for (int id = F.vcu * 4; id < 1024; id += F.G * 4)
            for (int k = 0; k < 4; ++k) { const int uid = id + k, bh = uid >> 6, qb = uid & 63, b = bh >> 3, h = bh & 7;
                const int ilo = (8 - 4 * qb) > 0 ? (8 - 4 * qb) : 0;
                attn_unit(F, QA, KA, VA, MIX, args.in[9], h, (long)b * SEQ + 256 * qb, (long)b * SEQ + 64 * (4 * qb - 8), ilo, 11, 8); }
        for (int uid = F.vcu; uid < 64; uid += F.G) { const int db = uid >> 3, h = uid & 7;
            attn_unit(F, QA, KA, VA, MIX, args.in[9], h, (long)MP + 64 * db, (long)MP + 576 * db, 0, 8, 2); }
        for (int it = F.vcu; it < 256; it += F.G) mlstm_stage1_item(F, it);
        if (BOTH(2)) GRID_BAR();
    }

    if (IN(3)) { p3_scan(F, args.in[15]); if (BOTH(3)) GRID_BAR(); }

    if (IN(4)) { for (int it = F.vcu; it < 288; it += F.G) mlstm_stage3_item(F, args, it); if (BOTH(4)) GRID_BAR(); }

    if (IN(5)) {
        pg8::Gemm g{(const bf16*)(F.ws + WS_MIX), (const bf16*)(F.ws + WS_WOUT), MT, DM, DM}; pg8::StaticOrder S; S.init(MT, DM, F.G, (int)blockIdx.x);
        EpiZ1 E{args.in[0], args.in[1], (bf16*)(F.ws + WS_Z1), (float*)(F.ws + WS_STAT1)};
        pg8::gemm_phase<EpiZ1, pg8::StaticOrder, true, true>(F.lds, g, S, E);
        if (BOTH(5)) GRID_BAR();
    }

    if (IN(6)) {
        pg8::Gemm g{(const bf16*)(F.ws + WS_Z1), (const bf16*)(F.ws + WS_W1), MT, FF, DM}; pg8::StaticOrder S; S.init(MT, FF, F.G, (int)blockIdx.x);
        EpiFfn1 E{(const float*)(F.ws + WS_STAT1), (const float*)(F.ws + WS_C1), (const float*)(F.ws + WS_C2), (bf16*)(F.ws + WS_HID)};
        pg8::gemm_phase<EpiFfn1, pg8::StaticOrder, true, true>(F.lds, g, S, E);
        if (BOTH(6)) GRID_BAR();
    }

    if (IN(7)) {
        pg8::Gemm g{(const bf16*)(F.ws + WS_HID), (const bf16*)(F.ws + WS_W2), MT, DM, FF}; pg8::StaticOrder S; S.init(MT, DM, F.G, (int)blockIdx.x);
        EpiFfn2 E{(const float*)(F.ws + WS_STAT1), (const bf16*)(F.ws + WS_Z1), args.in[12], args.in[13], args.in[17], F.out};
        pg8::gemm_phase<EpiFfn2, pg8::StaticOrder, true, true>(F.lds, g, S, E);
        if (BOTH(7)) GRID_BAR();
    }

    if (IN(8)) { p8_final_ln(F, args.in[18], args.in[19]); }
#undef IN
#undef BOTH
#undef GRID_BAR
}

extern "C" void kernel_launch(void* const* d_in, const int* in_sizes, int n_in, void* d_out, int out_size, void* d_ws, size_t ws_size, hipStream_t stream) {
    static int grid = 0;
    if (grid == 0) {
        if (n_in != 20 || out_size != (int)O_END || ws_size < WS_END) { fprintf(stderr, "kernel_launch: unexpected shapes: n_in %d out %d ws %zu (need %zu)\n", n_in, out_size, ws_size, (size_t)WS_END); grid = -1; return; }
        int dev = 0, cus = 0, per_cu = 0;
        if (hipGetDevice(&dev) != hipSuccess || hipDeviceGetAttribute(&cus, hipDeviceAttributeMultiprocessorCount, dev) != hipSuccess) { grid = -1; return; }
        if (hipFuncSetAttribute((const void*)hybrid_fwd, hipFuncAttributeMaxDynamicSharedMemorySize, LDS_BYTES) != hipSuccess) { fprintf(stderr, "kernel_launch: hipFuncSetAttribute failed\n"); grid = -1; return; }
        if (hipOccupancyMaxActiveBlocksPerMultiprocessor(&per_cu, (const void*)hybrid_fwd, 512, LDS_BYTES) != hipSuccess || per_cu < 1) { fprintf(stderr, "kernel_launch: occupancy query says %d\n", per_cu); (void)hipGetLastError(); grid = -1; return; }
        grid = cus;
    }
    if (grid < 0) return;
    Args a{};
    for (int i = 0; i < 20; ++i) a.in[i] = (const float*)d_in[i];
    a.out = (float*)d_out; a.ws = (unsigned char*)d_ws;
#if MK_N_LAUNCHES == 1
    a.ph_lo = 0; a.ph_hi = N_PHASES; a.coop = 1;
    void* kargs[] = {&a};
    hipError_t e = hipLaunchCooperativeKernel((const void*)hybrid_fwd, dim3(grid), dim3(512), kargs, LDS_BYTES, stream);
    if (e != hipSuccess) fprintf(stderr, "kernel_launch: cooperative launch failed: %s (grid %d)\n", hipGetErrorString(e), grid);
#else
    for (int p = 0; p < N_PHASES; ++p) {
        a.ph_lo = p; a.ph_hi = p + 1; a.coop = 0;
        hipLaunchKernelGGL(hybrid_fwd, dim3(grid), dim3(512), LDS_BYTES, stream, a);
    }
#endif
}
```

```cpp
#include <hip/hip_runtime.h>
#include <hip/hip_cooperative_groups.h>
#include <cstdio>
#include <cstdint>
namespace cg = cooperative_groups;

#ifndef MK_N_LAUNCHES
#define MK_N_LAUNCHES 1
#endif
#ifndef DUP_PHASE
#define DUP_PHASE 0
#endif

constexpr int DM = 1024, SEQ = 16384, NB = 2, DB = 8, DSEQ = 64;
constexpr int MP = NB * SEQ;
constexpr int MS = DB * DSEQ;
constexpr int MT = MP + MS;
constexpr int INW = 3592, NIN = 3584;
constexpr int AW = 512;
constexpr int FF = 4096;
constexpr int KVROWS = MP + DB * 576;
constexpr float LN_EPS = 1e-5f;
constexpr float ALPHA = 1.189207115002721f;
constexpr float LOG2E = 1.4426950408889634f;
constexpr float QSCALE = 0.125f * LOG2E;
constexpr float KBSCALE = 0.08838834764831845f;
constexpr size_t O_YP = 0, O_YS = 33554432, O_KP = 34078720, O_VP = 34603008, O_CP = 35127296, O_NP = 35258368, O_MP = 35259392,
                 O_KS = 35259400, O_VS = 35521544, O_CS = 35783688, O_NS = 36307976, O_MS = 36312072, O_END = 36312104;

constexpr size_t MiB = 1u << 20, KiB = 1024;
constexpr size_t WS_CTL = 0, CTL_ZERO_BYTES = 1 * MiB;
constexpr size_t WS_IG = 1 * MiB;
constexpr size_t WS_LF = 1 * MiB + 768 * KiB;
constexpr size_t WS_STAT1 = 2 * MiB + 512 * KiB;
constexpr size_t WS_C1P = 3 * MiB;
constexpr size_t WS_C2P = 3 * MiB + 256 * KiB;
constexpr size_t WS_C1 = 3 * MiB + 512 * KiB;
constexpr size_t WS_C2 = 3 * MiB + 528 * KiB;
constexpr size_t WS_SCNU = 3 * MiB + 768 * KiB;
constexpr size_t WS_STN = 3 * MiB + 896 * KiB;
constexpr size_t WS_SCML = 4 * MiB;
constexpr size_t WS_SCBS = 4 * MiB + 4 * KiB;
constexpr size_t WS_STM = 4 * MiB + 8 * KiB;
constexpr size_t WS_SCU = 5 * MiB;
constexpr size_t WS_STC = 21 * MiB;
constexpr size_t WS_WIN = 37 * MiB, WS_WOUT = 44 * MiB, WS_W1 = 46 * MiB, WS_W2 = 54 * MiB;
constexpr size_t WS_XB = 62 * MiB;
constexpr size_t WS_QA = 127 * MiB;
constexpr size_t WS_KA = WS_QA + 33 * MiB;
constexpr size_t WS_VA = WS_KA + 37 * MiB;
constexpr size_t WS_QB = WS_VA + 37 * MiB;
constexpr size_t WS_KB = WS_QB + 33 * MiB;
constexpr size_t WS_VB = WS_KB + 33 * MiB;
constexpr size_t WS_OG = WS_VB + 33 * MiB;
constexpr size_t WS_HID = 62 * MiB;
constexpr size_t WS_MIX = WS_OG + 33 * MiB;
constexpr size_t WS_Z1 = WS_MIX + 65 * MiB;
constexpr size_t WS_END = WS_Z1 + 65 * MiB;
static_assert(WS_HID + (size_t)MT * FF * 2 <= WS_OG, "HID overlay must not reach OG/MIX");
static_assert(WS_END <= 512 * MiB, "workspace map");
constexpr int CW_BAR = 4096;

constexpr int RING_BYTES = 131072;
constexpr int MISC_OFF = RING_BYTES + 320;
constexpr int LDS_BYTES = 147456;

#define GAS __attribute__((address_space(1)))
#define LAS __attribute__((address_space(3)))
typedef unsigned short bf16;
typedef unsigned v4u __attribute__((ext_vector_type(4)));
typedef unsigned v2u __attribute__((ext_vector_type(2)));
typedef float f32x4 __attribute__((ext_vector_type(4)));
typedef float f32x2 __attribute__((ext_vector_type(2)));
typedef float f32x16 __attribute__((ext_vector_type(16)));
typedef short bf16x8 __attribute__((ext_vector_type(8)));
typedef short s16x4 __attribute__((ext_vector_type(4)));
typedef GAS unsigned gu32;
#define RLX_AGENT __ATOMIC_RELAXED, __HIP_MEMORY_SCOPE_AGENT
#define LDS_WAIT() asm volatile("s_waitcnt lgkmcnt(0)" ::: "memory")
#define VM_WAIT() asm volatile("s_waitcnt vmcnt(0)" ::: "memory")

__device__ __forceinline__ unsigned f2bf(float f) { unsigned u = __builtin_bit_cast(unsigned, f); return (u + 0x7fffu + ((u >> 16) & 1u)) >> 16; }
__device__ __forceinline__ unsigned pk2(float lo, float hi) { return f2bf(lo) | (f2bf(hi) << 16); }
__device__ __forceinline__ float bflo(unsigned w) { return __builtin_bit_cast(float, w << 16); }
__device__ __forceinline__ float bfhi(unsigned w) { return __builtin_bit_cast(float, w & 0xffff0000u); }
__device__ __forceinline__ unsigned cvt_pk_bf16(float lo, float hi) { unsigned r; asm volatile("v_cvt_pk_bf16_f32 %0, %1, %2" : "=v"(r) : "v"(lo), "v"(hi)); return r; }
__device__ __forceinline__ float wave_sum(float v) {
#pragma unroll
    for (int o = 1; o < 64; o <<= 1) v += __shfl_xor(v, o);
    return v;
}
__device__ __forceinline__ int crow(int r, int hi) { return (r & 3) + 8 * (r >> 2) + 4 * hi; }
__device__ __forceinline__ float swap_max(float m) { auto rr = __builtin_amdgcn_permlane32_swap(__float_as_uint(m), __float_as_uint(m), false, false); return fmaxf(__uint_as_float(rr[0]), __uint_as_float(rr[1])); }
__device__ __forceinline__ float swap_add(float m) { auto rr = __builtin_amdgcn_permlane32_swap(__float_as_uint(m), __float_as_uint(m), false, false); return __uint_as_float(rr[0]) + __uint_as_float(rr[1]); }
typedef short v4i16_t __attribute__((ext_vector_type(4)));
__device__ __forceinline__ s16x4 trread(LAS const unsigned char* p) { return __builtin_bit_cast(s16x4, __builtin_amdgcn_ds_read_tr16_b64_v4i16((LAS v4i16_t*)p)); }
__device__ __forceinline__ bf16x8 trfrag(LAS const unsigned char* p) { const s16x4 lo = trread(p), hi = trread(p + 512); return (bf16x8){lo[0], lo[1], lo[2], lo[3], hi[0], hi[1], hi[2], hi[3]}; }

namespace pg8 {
#define PG8_LAS __attribute__((address_space(3)))
typedef unsigned short bf16_t;
typedef unsigned u32x4 __attribute__((ext_vector_type(4)));
constexpr int BM = 256, BK = 64, HALF = 128, HTB = HALF * BK * 2, STAGE_BYTES = 8 * HTB, NXCD = 8, WGM = 8;
__host__ __device__ __forceinline__ int lds_byte(int r, int c) { const int st = (r >> 4) * 2 + (c >> 5), rr = r & 15, cc = c & 31, ob = rr * 64 + cc * 2; return st * 1024 + (ob ^ (((ob >> 9) & 1) << 5)); }
__host__ __device__ __forceinline__ void stage_rc(int b, int& R, int& C) { const int st = b / 1024, sb = b % 1024, swz = sb ^ (((sb >> 9) & 1) << 5); R = (st >> 1) * 16 + swz / 64; C = (st & 1) * 32 + (swz % 64) / 2; }
__host__ __device__ __forceinline__ int perm32(int rho) { const int n = rho >> 4, i = rho & 15; return 8 * (i >> 2) + 4 * n + (i & 3); }
struct Unit { int pm, pn; };
struct Gemm { const bf16_t* A; const bf16_t* Bt; int M, N, K; };
struct StaticOrder {
    int nM, nN, nwg, G, c;
    __host__ __device__ void init(int M, int N, int G_, int c_) { nM = M / BM; nN = N / BM; nwg = nM * nN; G = G_; c = c_; }
    __host__ __device__ bool next(int i, Unit& u) const {
        const long L = (long)i * G + c; if (L >= nwg) return false;
        int wgid = (int)L; { const int q = nwg / NXCD, r = nwg % NXCD, xcd = wgid % NXCD, off = wgid / NXCD; wgid = (xcd < r ? xcd * (q + 1) : r * (q + 1) + (xcd - r) * q) + off; }
        const int nig = WGM * nN, gid = wgid / nig, fm = gid * WGM, gsz = (nM - fm) < WGM ? (nM - fm) : WGM;
        u.pm = fm + ((wgid % nig) % gsz); u.pn = (wgid % nig) / gsz; return true;
    }
    __device__ __forceinline__ void a_ready(const Unit&) const {}
    __device__ __forceinline__ void done(const Unit&) const {}
};

template <class Epi, class Sched, bool ALIGN_EPI = false, bool SP2 = false>
__device__ __forceinline__ void gemm_phase(PG8_LAS unsigned char* lds, const Gemm g, const Sched& S, const Epi& E) {
    const int tid = threadIdx.x, wid = __builtin_amdgcn_readfirstlane(tid >> 6), lane = tid & 63, wr = wid >> 2, wc = wid & 3, fr = lane & 15, fq = lane >> 4;
    const int K = g.K, nt = K / BK;
    unsigned voffA[2], voffB[2];
#pragma unroll
    for (int i = 0; i < 2; ++i) { int R, C; stage_rc(tid * 16 + i * 8192, R, C); const int Rb = Epi::PERM ? ((R & ~31) + perm32(R & 31)) : R;
        voffA[i] = (unsigned)(R * K + C) * 2u; voffB[i] = (unsigned)(Rb * K + C) * 2u; }
    const size_t kstep = (size_t)(BK * 2);
    const size_t hstep = (size_t)HALF * K * 2;
    const size_t tstep = 2 * hstep;
    const unsigned ldsw = (unsigned)wid * 1024u;
    const int aoff = lds_byte(wr * 64 + fr, fq * 8), boff = lds_byte(wc * 32 + fr, fq * 8);
#define PG8_SA(b, h) (((b) * 2 + (h)) * HTB)
#define PG8_SB(b, h) ((4 + (b) * 2 + (h)) * HTB)
#define PG8_STAGE(bufoff, gbase, voff) do { _Pragma("unroll") for (int _i = 0; _i < 2; ++_i) \
        __builtin_amdgcn_global_load_lds((const unsigned*)((const char*)(gbase) + (voff)[_i]), (PG8_LAS unsigned*)(lds + (bufoff) + ldsw + _i * 8192), 16, 0, 0); } while (0)
#define PG8_LDA(dst, b, h) do { _Pragma("unroll") for (int m = 0; m < 4; ++m) _Pragma("unroll") for (int k = 0; k < 2; ++k) dst[m][k] = *(const PG8_LAS bf16x8*)(lds + PG8_SA(b, h) + aoff + m * 2048 + k * 1024); } while (0)
#define PG8_LDB(dst, b, h) do { _Pragma("unroll") for (int n = 0; n < 2; ++n) _Pragma("unroll") for (int k = 0; k < 2; ++k) dst[n][k] = *(const PG8_LAS bf16x8*)(lds + PG8_SB(b, h) + boff + n * 2048 + k * 1024); } while (0)
#define PG8_MMA(ai, bj, At, Bt) do { __builtin_amdgcn_s_setprio(1); _Pragma("unroll") for (int m = 0; m < 4; ++m) _Pragma("unroll") for (int n = 0; n < 2; ++n) _Pragma("unroll") for (int k = 0; k < 2; ++k) \
        acc[ai][bj][m][n] = __builtin_amdgcn_mfma_f32_16x16x32_bf16(Bt[n][k], At[m][k], acc[ai][bj][m][n], 0, 0, 0); __builtin_amdgcn_s_setprio(0); } while (0)
#define PG8_WAIT_V(n) asm volatile("s_waitcnt vmcnt(" #n ")" ::: "memory")
#define PG8_WAIT_L(n) asm volatile("s_waitcnt lgkmcnt(" #n ")" ::: "memory")
#define PG8_BAR __builtin_amdgcn_s_barrier()
#define PG8_SCHED __builtin_amdgcn_sched_barrier(0)
    Unit cur, nxt; int ui = 0;
    if (!S.next(0, cur)) return;
    f32x4 acc[2][2][4][2];
#pragma unroll
    for (int a = 0; a < 2; ++a)
#pragma unroll
        for (int b = 0; b < 2; ++b)
#pragma unroll
            for (int m = 0; m < 4; ++m)
#pragma unroll
                for (int n = 0; n < 2; ++n) acc[a][b][m][n] = (f32x4){0.f, 0.f, 0.f, 0.f};
    bf16x8 At[4][2], B0[2][2], B1[2][2];
    const char* cA = (const char*)g.A + (size_t)cur.pm * tstep; const char* cB = (const char*)g.Bt + (size_t)cur.pn * tstep;
    S.a_ready(cur);
    if constexpr (SP2) {
        PG8_STAGE(PG8_SB(0, 0), cB, voffB); PG8_STAGE(PG8_SB(0, 1), cB + hstep, voffB); PG8_STAGE(PG8_SA(0, 0), cA, voffA); PG8_STAGE(PG8_SA(0, 1), cA + hstep, voffA);
        if (wr == 1) PG8_BAR;
        PG8_WAIT_V(2); PG8_BAR;
        PG8_STAGE(PG8_SB(1, 0), cB + kstep, voffB); PG8_STAGE(PG8_SA(1, 0), cA + kstep, voffA); PG8_STAGE(PG8_SB(1, 1), cB + hstep + kstep, voffB);
        PG8_WAIT_V(6); PG8_BAR;
    } else {
        PG8_STAGE(PG8_SB(0, 0), cB, voffB); PG8_STAGE(PG8_SA(0, 0), cA, voffA); PG8_STAGE(PG8_SB(0, 1), cB + hstep, voffB); PG8_STAGE(PG8_SA(0, 1), cA + hstep, voffA);
        if (wr == 1) PG8_BAR;
        PG8_WAIT_V(4); PG8_BAR;
        PG8_STAGE(PG8_SB(1, 0), cB + kstep, voffB); PG8_STAGE(PG8_SA(1, 0), cA + kstep, voffA); PG8_STAGE(PG8_SB(1, 1), cB + hstep + kstep, voffB);
        PG8_WAIT_V(6); PG8_BAR;
    }
    for (;;) {
        const bool has_next = S.next(ui + 1, nxt);
        const char* nA = has_next ? (const char*)g.A + (size_t)nxt.pm * tstep : cA; const char* nB = has_next ? (const char*)g.Bt + (size_t)nxt.pn * tstep : cB;
        for (int t = 0; t < nt; t += 2) {
            const bool last = (t == nt - 2);
            const char* a1 = cA + (size_t)(t + 1) * kstep;
            const char* a2 = last ? nA : cA + (size_t)(t + 2) * kstep; const char* b2 = last ? nB : cB + (size_t)(t + 2) * kstep;
            const char* a3 = a2 + kstep; const char* b3 = b2 + kstep;
            if (last && has_next) S.a_ready(nxt);
            if constexpr (SP2) {
            PG8_LDB(B0, 0, 0); PG8_LDB(B1, 0, 1); PG8_SCHED; PG8_LDA(At, 0, 0); PG8_STAGE(PG8_SA(1, 1), a1 + hstep, voffA);
            PG8_WAIT_V(8); PG8_WAIT_L(0); PG8_BAR; PG8_MMA(0, 0, At, B0); PG8_MMA(0, 1, At, B1); PG8_BAR; PG8_SCHED;
            PG8_LDA(At, 0, 1); PG8_STAGE(PG8_SB(0, 0), b2, voffB); PG8_STAGE(PG8_SB(0, 1), b2 + hstep, voffB); PG8_STAGE(PG8_SA(0, 0), a2, voffA);
            PG8_WAIT_V(8); PG8_WAIT_L(0); PG8_BAR; PG8_MMA(1, 0, At, B0); PG8_MMA(1, 1, At, B1); PG8_BAR; PG8_SCHED;
            PG8_LDB(B0, 1, 0); PG8_LDB(B1, 1, 1); PG8_SCHED; PG8_LDA(At, 1, 0); PG8_STAGE(PG8_SA(0, 1), a2 + hstep, voffA);
            PG8_WAIT_V(8); PG8_WAIT_L(0); PG8_BAR; PG8_MMA(0, 0, At, B0); PG8_MMA(0, 1, At, B1); PG8_BAR; PG8_SCHED;
            PG8_LDA(At, 1, 1); PG8_STAGE(PG8_SB(1, 0), b3, voffB); PG8_STAGE(PG8_SB(1, 1), b3 + hstep, voffB); PG8_STAGE(PG8_SA(1, 0), a3, voffA);
            PG8_WAIT_V(8); PG8_WAIT_L(0); PG8_BAR; PG8_MMA(1, 0, At, B0); PG8_MMA(1, 1, At, B1); PG8_BAR; PG8_SCHED;
            } else {
            PG8_LDB(B0, 0, 0); PG8_SCHED; PG8_LDA(At, 0, 0); PG8_STAGE(PG8_SA(1, 1), a1 + hstep, voffA);
            PG8_WAIT_L(8); PG8_BAR; PG8_WAIT_L(0); PG8_MMA(0, 0, At, B0); PG8_BAR; PG8_SCHED;
            PG8_LDB(B1, 0, 1); PG8_STAGE(PG8_SB(0, 0), b2, voffB);
            PG8_BAR; PG8_WAIT_L(0); PG8_MMA(0, 1, At, B1); PG8_BAR;
            PG8_LDA(At, 0, 1); PG8_STAGE(PG8_SA(0, 0), a2, voffA);
            PG8_BAR; PG8_WAIT_L(0); PG8_MMA(1, 0, At, B0); PG8_BAR; PG8_SCHED;
            PG8_STAGE(PG8_SB(0, 1), b2 + hstep, voffB);
            PG8_WAIT_V(6); PG8_BAR; PG8_MMA(1, 1, At, B1); PG8_BAR;
            PG8_LDB(B0, 1, 0); PG8_SCHED; PG8_LDA(At, 1, 0); PG8_STAGE(PG8_SA(0, 1), a2 + hstep, voffA);
            PG8_WAIT_L(8); PG8_BAR; PG8_WAIT_L(0); PG8_MMA(0, 0, At, B0); PG8_BAR; PG8_SCHED;
            PG8_LDB(B1, 1, 1); PG8_STAGE(PG8_SB(1, 0), b3, voffB);
            PG8_BAR; PG8_WAIT_L(0); PG8_MMA(0, 1, At, B1); PG8_BAR;
            PG8_LDA(At, 1, 1); PG8_STAGE(PG8_SA(1, 0), a3, voffA);
            PG8_BAR; PG8_WAIT_L(0); PG8_MMA(1, 0, At, B0); PG8_BAR; PG8_SCHED;
            PG8_STAGE(PG8_SB(1, 1), b3 + hstep, voffB);
            PG8_WAIT_V(6); PG8_BAR; PG8_MMA(1, 1, At, B1); PG8_BAR;
            }
        }
        if constexpr (ALIGN_EPI) { if (wr == 0) PG8_BAR; }
        E(acc, cur, wr, wc, fr, fq); S.done(cur);
        if (!has_next) break;
#pragma unroll
        for (int a = 0; a < 2; ++a)
#pragma unroll
            for (int b = 0; b < 2; ++b)
#pragma unroll
                for (int m = 0; m < 4; ++m)
#pragma unroll
                    for (int n = 0; n < 2; ++n) acc[a][b][m][n] = (f32x4){0.f, 0.f, 0.f, 0.f};
        cur = nxt; cA = nA; cB = nB; ++ui;
        if constexpr (ALIGN_EPI) { if (wr == 1) PG8_BAR; }
    }
    PG8_WAIT_V(0);
    if constexpr (!ALIGN_EPI) { if (wr == 0) PG8_BAR; }
    PG8_BAR;
#undef PG8_SA
#undef PG8_SB
#undef PG8_STAGE
#undef PG8_LDA
#undef PG8_LDB
#undef PG8_MMA
#undef PG8_WAIT_V
#undef PG8_WAIT_L
#undef PG8_BAR
#undef PG8_SCHED
}
}

struct EpiInProj {
    static constexpr bool PERM = true;
    unsigned char* ws; const float* bias; float* out;
    __device__ __forceinline__ void operator()(const f32x4 (&acc)[2][2][4][2], const pg8::Unit& u, int wr, int wc, int fr, int fq) const {
        const int colt = u.pn * 256, t = colt >> 9, cl = colt & 511;
        bf16* base = (bf16*)(ws + WS_QA + (size_t)t * (33 * MiB) + (t >= 2 ? 4 * MiB : 0) + (t >= 3 ? 4 * MiB : 0));
        const float sc = (t == 0) ? QSCALE : ((t == 4) ? KBSCALE : 1.f);
        const int row0 = u.pm * 256 + wr * 64 + fr, col0 = cl + wc * 32 + 8 * fq, bcol0 = colt + wc * 32 + 8 * fq;
        const bool kv = (t == 1 || t == 2);
        const bool ptail = kv && ((u.pm & 63) >= 62) && (u.pm < 128);
        const bool samp = (u.pm >= 128);
        const bool wf32 = kv && (samp || ptail);
        const size_t foff = (samp ? O_KS : O_KP) + ((t == 2) ? (samp ? (O_VS - O_KS) : (O_VP - O_KP)) : (size_t)0);
        float* of32 = out + foff;
        f32x4 bv[2][2];
#pragma unroll
        for (int bj = 0; bj < 2; ++bj)
#pragma unroll
            for (int n = 0; n < 2; ++n) bv[bj][n] = *(const f32x4*)(bias + bcol0 + bj * 128 + 4 * n);
#pragma unroll
        for (int ai = 0; ai < 2; ++ai)
#pragma unroll
            for (int m = 0; m < 4; ++m) {
                const int row = row0 + ai * 128 + m * 16;
                int orow = row;
                if (kv && samp) { const int s = row - MP; orow = MP + (s >> 6) * 576 + 512 + (s & 63); }
                long frow = 0;
                if (wf32) frow = samp ? (long)(row - MP) : (long)((row >> 14) * 512 + ((row & (SEQ - 1)) - (SEQ - 512)));
#pragma unroll
                for (int bj = 0; bj < 2; ++bj) {
                    f32x4 v0 = acc[ai][bj][m][0] + bv[bj][0], v1 = acc[ai][bj][m][1] + bv[bj][1];
                    if (wf32) { float* fp = of32 + frow * 512 + col0 + bj * 128; *(f32x4*)fp = v0; *(f32x4*)(fp + 4) = v1; }
                    if (t == 6) {
#pragma unroll
                        for (int e = 0; e < 4; ++e) { v0[e] = __builtin_amdgcn_rcpf(1.f + __expf(-v0[e])); v1[e] = __builtin_amdgcn_rcpf(1.f + __expf(-v1[e])); }
                    }
                    v0 = v0 * sc; v1 = v1 * sc;
                    v4u w; w.x = cvt_pk_bf16(v0[0], v0[1]); w.y = cvt_pk_bf16(v0[2], v0[3]); w.z = cvt_pk_bf16(v1[0], v1[1]); w.w = cvt_pk_bf16(v1[2], v1[3]);
                    *(v4u*)(base + (size_t)orow * AW + col0 + bj * 128) = w;
                }
            }
    }
};
struct EpiZ1 {
    static constexpr bool PERM = true;
    const float* xp; const float* xs; bf16* z1; float* stat; bool do_stat;
    __device__ __forceinline__ void operator()(const f32x4 (&acc)[2][2][4][2], const pg8::Unit& u, int wr, int wc, int fr, int fq) const {
        const int row0 = u.pm * 256 + wr * 64 + fr, col0 = u.pn * 256 + wc * 32 + 8 * fq;
#pragma unroll
        for (int ai = 0; ai < 2; ++ai)
#pragma unroll
            for (int m = 0; m < 4; ++m) {
                const int row = row0 + ai * 128 + m * 16;
                const float* xr = (row < MP) ? xp + (size_t)row * DM : xs + (size_t)(row - MP) * DM;
                float s = 0.f, q = 0.f;
#pragma unroll
                for (int bj = 0; bj < 2; ++bj) {
                    const f32x4 x0 = *(const f32x4*)(xr + col0 + bj * 128), x1 = *(const f32x4*)(xr + col0 + bj * 128 + 4);
                    const f32x4 v0 = x0 * ALPHA + acc[ai][bj][m][0], v1 = x1 * ALPHA + acc[ai][bj][m][1];
                    s += (v0[0] + v0[1]) + (v0[2] + v0[3]) + (v1[0] + v1[1]) + (v1[2] + v1[3]);
                    q += (v0[0] * v0[0] + v0[1] * v0[1]) + (v0[2] * v0[2] + v0[3] * v0[3]) + (v1[0] * v1[0] + v1[1] * v1[1]) + (v1[2] * v1[2] + v1[3] * v1[3]);
                    v4u w; w.x = cvt_pk_bf16(v0[0], v0[1]); w.y = cvt_pk_bf16(v0[2], v0[3]); w.z = cvt_pk_bf16(v1[0], v1[1]); w.w = cvt_pk_bf16(v1[2], v1[3]);
                    *(v4u*)(z1 + (size_t)row * DM + col0 + bj * 128) = w;
                }
                s += __shfl_xor(s, 16); s += __shfl_xor(s, 32); q += __shfl_xor(q, 16); q += __shfl_xor(q, 32);
                if (fq == 0 && do_stat) { atomicAdd(stat + 2 * row, s); atomicAdd(stat + 2 * row + 1, q); }
            }
    }
};
struct EpiFfn1 {
    static constexpr bool PERM = true;
    const float* stat; const float* c1; const float* c2; bf16* hid;
    __device__ __forceinline__ void operator()(const f32x4 (&acc)[2][2][4][2], const pg8::Unit& u, int wr, int wc, int fr, int fq) const {
        const int row0 = u.pm * 256 + wr * 64 + fr, col0 = u.pn * 256 + wc * 32 + 8 * fq;
        f32x4 k1[2][2], k2[2][2];
#pragma unroll
        for (int bj = 0; bj < 2; ++bj)
#pragma unroll
            for (int n = 0; n < 2; ++n) { k1[bj][n] = *(const f32x4*)(c1 + col0 + bj * 128 + 4 * n); k2[bj][n] = *(const f32x4*)(c2 + col0 + bj * 128 + 4 * n); }
#pragma unroll
        for (int ai = 0; ai < 2; ++ai)
#pragma unroll
            for (int m = 0; m < 4; ++m) {
                const int row = row0 + ai * 128 + m * 16;
                const f32x2 st = *(const f32x2*)(stat + 2 * row);
                const float mean = st.x * (1.f / DM), var = fmaxf(st.y * (1.f / DM) - mean * mean, 0.f), rstd = 1.0f / sqrtf(var + LN_EPS);
#pragma unroll
                for (int bj = 0; bj < 2; ++bj) {
                    f32x4 v0 = (acc[ai][bj][m][0] - k1[bj][0] * mean) * rstd + k2[bj][0], v1 = (acc[ai][bj][m][1] - k1[bj][1] * mean) * rstd + k2[bj][1];
#pragma unroll
                    for (int e = 0; e < 4; ++e) { const float a = fmaxf(v0[e], 0.f), b = fmaxf(v1[e], 0.f); v0[e] = a * a; v1[e] = b * b; }
                    v4u w; w.x = cvt_pk_bf16(v0[0], v0[1]); w.y = cvt_pk_bf16(v0[2], v0[3]); w.z = cvt_pk_bf16(v1[0], v1[1]); w.w = cvt_pk_bf16(v1[2], v1[3]);
                    *(v4u*)(hid + (size_t)row * FF + col0 + bj * 128) = w;
                }
            }
    }
};
struct EpiFfn2 {
    static constexpr bool PERM = true;
    const float* stat; const bf16* z1; const float* g1; const float* b1; const float* bias; float* out;
    __device__ __forceinline__ void operator()(const f32x4 (&acc)[2][2][4][2], const pg8::Unit& u, int wr, int wc, int fr, int fq) const {
        const int row0 = u.pm * 256 + wr * 64 + fr, col0 = u.pn * 256 + wc * 32 + 8 * fq;
        f32x4 gg[2][2], bb[2][2], bo[2][2];
#pragma unroll
        for (int bj = 0; bj < 2; ++bj)
#pragma unroll
            for (int n = 0; n < 2; ++n) { gg[bj][n] = *(const f32x4*)(g1 + col0 + bj * 128 + 4 * n); bb[bj][n] = *(const f32x4*)(b1 + col0 + bj * 128 + 4 * n); bo[bj][n] = *(const f32x4*)(bias + col0 + bj * 128 + 4 * n); }
#pragma unroll
        for (int ai = 0; ai < 2; ++ai)
#pragma unroll
            for (int m = 0; m < 4; ++m) {
                const int row = row0 + ai * 128 + m * 16;
                const f32x2 st = *(const f32x2*)(stat + 2 * row);
                const float mean = st.x * (1.f / DM), var = fmaxf(st.y * (1.f / DM) - mean * mean, 0.f), rstd = 1.0f / sqrtf(var + LN_EPS);
#pragma unroll
                for (int bj = 0; bj < 2; ++bj) {
                    const v4u zz = *(const v4u*)(z1 + (size_t)row * DM + col0 + bj * 128);
                    const f32x4 z0 = (f32x4){bflo(zz.x), bfhi(zz.x), bflo(zz.y), bfhi(zz.y)}, z1v = (f32x4){bflo(zz.z), bfhi(zz.z), bflo(zz.w), bfhi(zz.w)};
                    const f32x4 h0 = (z0 - mean) * rstd * gg[bj][0] + bb[bj][0], h1 = (z1v - mean) * rstd * gg[bj][1] + bb[bj][1];
                    const f32x4 o0 = h0 * ALPHA + acc[ai][bj][m][0] + bo[bj][0], o1 = h1 * ALPHA + acc[ai][bj][m][1] + bo[bj][1];
                    float* op = out + (size_t)row * DM + col0 + bj * 128;
                    *(f32x4*)op = o0; *(f32x4*)(op + 4) = o1;
                }
            }
    }
};

struct Args { const float* in[20]; float* out; unsigned char* ws; int ph_lo, ph_hi, coop, pad; };
struct Frame {
    LAS unsigned char* lds;
    int tid, lane, wave, vcu, G;
    float* out; unsigned char* ws;
};

template <bool FOLD>
__device__ __forceinline__ void p0_transpose_item(const float* W, int K, int N, int ldw, bf16* WT, LAS float* scr, int item, int lane,
                                                  const float* g, const float* b, float* c1p, float* c2p) {
    const int nblk = N / 32, kb = item / nblk, nb = item % nblk, k0 = 64 * kb, n0 = 32 * nb;
#pragma unroll 8
    for (int i = 0; i < 32; ++i) { const int kk = 2 * i + (lane >> 5); scr[kk * 33 + (lane & 31)] = W[(size_t)(k0 + kk) * ldw + n0 + (lane & 31)]; }
    LDS_WAIT(); asm volatile("" ::: "memory");
    if constexpr (FOLD) {
        const int n = lane & 31, hf = lane >> 5; float s1 = 0.f, s2 = 0.f;
#pragma unroll 8
        for (int i = 0; i < 32; ++i) { const int kk = hf * 32 + i; const float w = scr[kk * 33 + n]; const float gw = w * g[k0 + kk];
            const float gr = __builtin_bit_cast(float, f2bf(gw) << 16); s1 += gr; s2 += w * b[k0 + kk]; scr[kk * 33 + n] = gw; }
        s1 += __shfl_xor(s1, 32); s2 += __shfl_xor(s2, 32);
        if (lane < 32) { c1p[(size_t)kb * N + n0 + n] = s1; c2p[(size_t)kb * N + n0 + n] = s2; }
        LDS_WAIT(); asm volatile("" ::: "memory");
    }
    const int c = lane & 7;
#pragma unroll
    for (int j = 0; j < 4; ++j) { const int n = (lane >> 3) + 8 * j; const LAS float* s = scr + (8 * c) * 33 + n;
        v4u o; o.x = pk2(s[0 * 33], s[1 * 33]); o.y = pk2(s[2 * 33], s[3 * 33]); o.z = pk2(s[4 * 33], s[5 * 33]); o.w = pk2(s[6 * 33], s[7 * 33]);
        *(GAS v4u*)(WT + (size_t)(n0 + n) * K + k0 + 8 * c) = o; }
    LDS_WAIT(); asm volatile("" ::: "memory");
}

__device__ __forceinline__ void p0_prologue(Frame& F, const Args& A) {
    const float* xp = A.in[0]; const float* xs = A.in[1]; const float* ck = A.in[2]; const float* cv = A.in[3];
    const float* w_in = A.in[7]; const float* b_in = A.in[8]; const float* w_out = A.in[11]; const float* ln1g = A.in[12]; const float* ln1b = A.in[13];
    const float* w1 = A.in[14]; const float* w2 = A.in[16];
    bf16* WIN = (bf16*)(F.ws + WS_WIN); bf16* WOUT = (bf16*)(F.ws + WS_WOUT); bf16* W1T = (bf16*)(F.ws + WS_W1); bf16* W2T = (bf16*)(F.ws + WS_W2);
    bf16* XB = (bf16*)(F.ws + WS_XB); bf16* KA = (bf16*)(F.ws + WS_KA); bf16* VA = (bf16*)(F.ws + WS_VA);
    float* IG = (float*)(F.ws + WS_IG); float* LFp = (float*)(F.ws + WS_LF); float* STAT = (float*)(F.ws + WS_STAT1);
    float* C1P = (float*)(F.ws + WS_C1P); float* C2P = (float*)(F.ws + WS_C2P);
    LAS float* scr = (LAS float*)(F.lds + F.wave * 8704);
    LAS float* wg = (LAS float*)(F.lds + 98304);
    const int gw = F.vcu * 8 + F.wave, NGW = F.G * 8;
    for (int k = F.tid; k < DM; k += 512) { const f32x4 a = *(const f32x4*)(w_in + (size_t)k * INW + NIN), b = *(const f32x4*)(w_in + (size_t)k * INW + NIN + 4);
        wg[0 * DM + k] = a[0]; wg[1 * DM + k] = a[1]; wg[2 * DM + k] = a[2]; wg[3 * DM + k] = a[3]; wg[4 * DM + k] = b[0]; wg[5 * DM + k] = b[1]; wg[6 * DM + k] = b[2]; wg[7 * DM + k] = b[3]; }
    for (int i = (int)blockIdx.x * 512 + F.tid; i < MT * 2; i += F.G * 512) STAT[i] = 0.f;
    __syncthreads();
    constexpr int I_IN = (DM / 64) * (NIN / 32), I_OUT = (DM / 64) * (DM / 32), I_1 = (DM / 64) * (FF / 32), I_2 = (FF / 64) * (DM / 32);
    constexpr int NITEMS = I_IN + I_OUT + I_1 + I_2;
    for (int it = gw; it < NITEMS; it += NGW) {
        int r = it;
        if (r < I_IN) { p0_transpose_item<false>(w_in, DM, NIN, INW, WIN, scr, r, F.lane, nullptr, nullptr, nullptr, nullptr); continue; } r -= I_IN;
        if (r < I_OUT) { p0_transpose_item<false>(w_out, DM, DM, DM, WOUT, scr, r, F.lane, nullptr, nullptr, nullptr, nullptr); continue; } r -= I_OUT;
        if (r < I_1) { p0_transpose_item<true>(w1, DM, FF, FF, W1T, scr, r, F.lane, ln1g, ln1b, C1P, C2P); continue; } r -= I_1;
        p0_transpose_item<false>(w2, FF, DM, DM, W2T, scr, r, F.lane, nullptr, nullptr, nullptr, nullptr);
    }
    for (int m = gw; m < MT; m += NGW) {
        const float* xrow = (m < MP) ? xp + (size_t)m * DM : xs + (size_t)(m - MP) * DM;
        const GAS f32x4* xr = (const GAS f32x4*)xrow + F.lane;
        f32x4 v[4]; float a[8];
#pragma unroll
        for (int g = 0; g < 8; ++g) a[g] = 0.f;
#pragma unroll
        for (int j = 0; j < 4; ++j) v[j] = xr[64 * j];
#pragma unroll
        for (int j = 0; j < 4; ++j)
#pragma unroll
            for (int g = 0; g < 8; ++g) { const f32x4 w = *(const LAS f32x4*)(wg + g * DM + 256 * j + 4 * F.lane); a[g] += (v[j][0] * w[0] + v[j][1] * w[1]) + (v[j][2] * w[2] + v[j][3] * w[3]); }
        GAS unsigned long long* o8 = (GAS unsigned long long*)(XB + (size_t)m * DM) + F.lane;
#pragma unroll
        for (int j = 0; j < 4; ++j) o8[64 * j] = (unsigned long long)pk2(v[j][0], v[j][1]) | ((unsigned long long)pk2(v[j][2], v[j][3]) << 32);
#pragma unroll
        for (int g = 0; g < 8; ++g) a[g] = wave_sum(a[g]);
        if (F.lane < 8) {
            float val = a[0];
#pragma unroll
            for (int g = 1; g < 8; ++g) val = (F.lane == g) ? a[g] : val;
            val += b_in[NIN + F.lane];
            if (F.lane < 4) IG[(size_t)m * 4 + F.lane] = val;
            else { const float ls = fminf(val, 0.f) - log1pf(__expf(-fabsf(val))); LFp[(size_t)m * 4 + F.lane - 4] = ls; }
        }
    }
    for (int it = gw; it < 2 * DB * 512; it += NGW) {
        const int which = it >= DB * 512, r = which ? it - DB * 512 : it, db = r >> 9, rr = r & 511;
        const float* src = (which ? cv : ck) + (size_t)r * AW + 8 * F.lane;
        const f32x4 a = *(const f32x4*)src, b = *(const f32x4*)(src + 4);
        v4u o; o.x = pk2(a[0], a[1]); o.y = pk2(a[2], a[3]); o.z = pk2(b[0], b[1]); o.w = pk2(b[2], b[3]);
        *(v4u*)((which ? VA : KA) + (size_t)(MP + db * 576 + rr) * AW + 8 * F.lane) = o;
    }
}

constexpr int AT_K = 0, AT_V = 16384, AT_BIAS = 32768, AT_WS = 34816, AT_OST = 36864;
__device__ __forceinline__ void attn_unit(Frame& F, const bf16* Q, const bf16* K, const bf16* V, bf16* MIX, const float* relb,
                                          int h, long qrow_base, long kv_base, int i_lo, int i_hi, int nactive) {
    const int tid = F.tid, lane = F.lane, r32 = lane & 31, hi = lane >> 5, wid = F.wave;
    const int wq = wid >> 1, wh = wid & 1;
    const bool active = wid < nactive;
    LAS unsigned char* lds = F.lds;
    LAS float* bias = (LAS float*)(lds + AT_BIAS);
    LAS float* wsf = (LAS float*)(lds + AT_WS) + wid * 64;
    if (tid < 257) bias[tid] = relb[h * 257 + tid] * LOG2E;
    const long qrow = qrow_base + 64 * wq + 32 * wh;
    bf16x8 qr[4];
#pragma unroll
    for (int d0 = 0; d0 < 4; ++d0) qr[d0] = (bf16x8){0, 0, 0, 0, 0, 0, 0, 0};
    if (active) {
#pragma unroll
        for (int d0 = 0; d0 < 4; ++d0) qr[d0] = *(const bf16x8*)(Q + (qrow + r32) * AW + h * 64 + d0 * 16 + hi * 8);
    }
    float m_run = -1e30f, l_run = 0.f;
    f32x16 o[2];
#pragma unroll
    for (int r = 0; r < 16; ++r) { o[0][r] = 0.f; o[1][r] = 0.f; }
    const unsigned ldsw = (unsigned)wid * 1024u;
#define AT_STAGE(i_, buf_) do { const long trow = kv_base + 64 * (long)(i_); \
        const bf16* ksrc = K + (trow + lane) * AW + h * 64 + wid * 8; \
        const bf16* vsrc = V + (trow + 16 * (wid & 3) + (lane >> 2)) * AW + h * 64 + (wid >> 2) * 32 + (lane & 3) * 8; \
        __builtin_amdgcn_global_load_lds((const unsigned*)ksrc, (LAS unsigned*)(lds + AT_K + (buf_) * 8192 + ldsw), 16, 0, 0); \
        __builtin_amdgcn_global_load_lds((const unsigned*)vsrc, (LAS unsigned*)(lds + AT_V + (buf_) * 8192 + ldsw), 16, 0, 0); } while (0)
    AT_STAGE(i_lo, 0);
    int cur = 0;
    for (int i = i_lo; i <= i_hi; ++i) {
        VM_WAIT(); __syncthreads();
        if (i + 1 <= i_hi) AT_STAGE(i + 1, cur ^ 1);
        if (active && i >= wq && i <= wq + 8) {
            const int delta = wq + 8 - i;
            const LAS unsigned char* kb = lds + AT_K + cur * 8192 + hi * 1024 + r32 * 16;
            const float cinit = (delta >= 3) ? bias[256] : 0.f;
            f32x16 p0, p1;
#pragma unroll
            for (int r = 0; r < 16; ++r) { p0[r] = cinit; p1[r] = cinit; }
#pragma unroll
            for (int d0 = 0; d0 < 4; ++d0) {
                const bf16x8 b0 = *(const LAS bf16x8*)(kb + d0 * 2048), b1 = *(const LAS bf16x8*)(kb + d0 * 2048 + 512);
                p0 = __builtin_amdgcn_mfma_f32_32x32x16_bf16(b0, qr[d0], p0, 0, 0, 0);
                p1 = __builtin_amdgcn_mfma_f32_32x32x16_bf16(b1, qr[d0], p1, 0, 0, 0);
            }
            if (delta <= 2) {
                const int bs = 64 * delta + 32 * wh + r32 + 128;
#pragma unroll
                for (int r = 0; r < 16; ++r) { const int kj = crow(r, hi); int i0 = bs - kj, i1 = bs - kj - 32; i0 = i0 > 256 ? 256 : i0; i1 = i1 > 256 ? 256 : i1; i0 = i0 < 0 ? 0 : i0; i1 = i1 < 0 ? 0 : i1;
                    p0[r] += bias[i0]; p1[r] += bias[i1]; }
            }
            float rm = fmaxf(p0[0], p1[0]);
#pragma unroll
            for (int r = 1; r < 16; ++r) rm = fmaxf(rm, fmaxf(p0[r], p1[r]));
            rm = swap_max(rm);
            if (__any(rm > m_run)) {
                const float mn = fmaxf(m_run, rm), f = __builtin_amdgcn_exp2f(m_run - mn);
                l_run *= f; m_run = mn;
                if (hi == 0) wsf[r32] = f;
                LDS_WAIT();
#pragma unroll
                for (int r = 0; r < 16; ++r) { const float fr_ = wsf[crow(r, hi)]; o[0][r] *= fr_; o[1][r] *= fr_; }
                LDS_WAIT();
            }
            float sacc = 0.f;
#pragma unroll
            for (int r = 0; r < 16; ++r) { p0[r] = __builtin_amdgcn_exp2f(p0[r] - m_run); p1[r] = __builtin_amdgcn_exp2f(p1[r] - m_run); sacc += p0[r] + p1[r]; }
            l_run += sacc;
            v4u pw[4];
            pw[0] = (v4u){cvt_pk_bf16(p0[0], p0[1]), cvt_pk_bf16(p0[2], p0[3]), cvt_pk_bf16(p0[4], p0[5]), cvt_pk_bf16(p0[6], p0[7])};
            pw[1] = (v4u){cvt_pk_bf16(p0[8], p0[9]), cvt_pk_bf16(p0[10], p0[11]), cvt_pk_bf16(p0[12], p0[13]), cvt_pk_bf16(p0[14], p0[15])};
            pw[2] = (v4u){cvt_pk_bf16(p1[0], p1[1]), cvt_pk_bf16(p1[2], p1[3]), cvt_pk_bf16(p1[4], p1[5]), cvt_pk_bf16(p1[6], p1[7])};
            pw[3] = (v4u){cvt_pk_bf16(p1[8], p1[9]), cvt_pk_bf16(p1[10], p1[11]), cvt_pk_bf16(p1[12], p1[13]), cvt_pk_bf16(p1[14], p1[15])};
            const LAS unsigned char* vb = lds + AT_V + cur * 8192 + ((lane >> 4) & 1) * 32 + (lane & 3) * 8 + (4 * hi + ((lane & 15) >> 2)) * 64;
#pragma unroll
            for (int d0 = 0; d0 < 2; ++d0)
#pragma unroll
                for (int ks = 0; ks < 4; ++ks) {
                    const bf16x8 vf = trfrag(vb + d0 * 4096 + ks * 1024);
                    o[d0] = __builtin_amdgcn_mfma_f32_32x32x16_bf16(__builtin_bit_cast(bf16x8, pw[ks]), vf, o[d0], 0, 0, 0);
                }
        }
        cur ^= 1;
    }
    if (active) {
        const float lt = swap_add(l_run);
        if (hi == 0) wsf[32 + r32] = lt;
        LDS_WAIT();
        LAS bf16* stg = (LAS bf16*)(lds + AT_OST) + wid * 2048;
#pragma unroll
        for (int r = 0; r < 16; ++r) { const int orow = crow(r, hi); const float rl = __builtin_amdgcn_rcpf(wsf[32 + orow]);
            stg[orow * 64 + r32] = (bf16)f2bf(o[0][r] * rl); stg[orow * 64 + 32 + r32] = (bf16)f2bf(o[1][r] * rl); }
        LDS_WAIT();
#pragma unroll
        for (int i = 0; i < 4; ++i) { const int row = i * 8 + (lane >> 3), ch = lane & 7; const v4u v = *(const LAS v4u*)(stg + row * 64 + ch * 8);
            *(v4u*)(MIX + (qrow + row) * DM + h * 64 + ch * 8) = v; }
    }
    LDS_WAIT();
    __syncthreads();
#undef AT_STAGE
}

__device__ __forceinline__ int tr_off(int s, int c16) { return (c16 >> 2) * 4096 + (s >> 4) * 1024 + (s & 15) * 64 + (c16 & 3) * 16; }
__device__ __forceinline__ int tr_read_base(int lane) { const int hi = lane >> 5; return ((lane >> 4) & 1) * 32 + (lane & 3) * 8 + (4 * hi + ((lane & 15) >> 2)) * 64; }
__device__ __forceinline__ v4u scale8(v4u k, float w) {
    v4u o; o.x = pk2(bflo(k.x) * w, bfhi(k.x) * w); o.y = pk2(bflo(k.y) * w, bfhi(k.y) * w); o.z = pk2(bflo(k.z) * w, bfhi(k.z) * w); o.w = pk2(bflo(k.w) * w, bfhi(k.w) * w); return o;
}

__device__ __forceinline__ void mlstm_stage1_item(Frame& F, int item) {
    const int tid = F.tid, lane = F.lane, wid = F.wave, r32 = lane & 31, hi = lane >> 5;
    const int seq = item >> 5, j = item & 31, b = seq >> 2, h = seq & 3;
    const long row0 = (long)b * SEQ + (long)j * 512;
    const bf16* KB = (const bf16*)(F.ws + WS_KB); const bf16* VB = (const bf16*)(F.ws + WS_VB);
    const float* IG = (const float*)(F.ws + WS_IG); const float* LFp = (const float*)(F.ws + WS_LF);
    LAS unsigned char* lds = F.lds;
    LAS float* wts = (LAS float*)(lds + 32768); LAS float* red = (LAS float*)(lds + 34816);
    const float lfv = LFp[(row0 + tid) * 4 + h], igv = IG[(row0 + tid) * 4 + h];
    float bs = lfv;
#pragma unroll
    for (int off = 1; off < 64; off <<= 1) { const float t = __shfl_up(bs, off); if (lane >= off) bs += t; }
    if (lane == 63) red[wid] = bs;
    __syncthreads();
    float woff = 0.f, btot = 0.f;
#pragma unroll
    for (int w = 0; w < 8; ++w) { const float t = red[w]; if (w < wid) woff += t; btot += t; }
    bs += woff;
    const float e = btot - bs + igv;
    float mx = e;
#pragma unroll
    for (int o = 1; o < 64; o <<= 1) mx = fmaxf(mx, __shfl_xor(mx, o));
    if (lane == 0) red[16 + wid] = mx;
    __syncthreads();
    float mloc = red[16];
#pragma unroll
    for (int w = 1; w < 8; ++w) mloc = fmaxf(mloc, red[16 + w]);
    wts[tid] = __expf(e - mloc);
    __syncthreads();
    f32x16 acc[2];
#pragma unroll
    for (int r = 0; r < 16; ++r) { acc[0][r] = 0.f; acc[1][r] = 0.f; }
    float nsum = 0.f;
    const int kb = wid >> 1, vb0 = 2 * (wid & 1);
    const int trb = tr_read_base(lane);
    for (int c = 0; c < 8; ++c) {
        v4u kv[2], vv[2];
#pragma unroll
        for (int i = 0; i < 2; ++i) { const int p = tid + 512 * i, row = p >> 4, c16 = p & 15;
            kv[i] = *(const v4u*)(KB + (row0 + c * 64 + row) * AW + h * 128 + c16 * 8); vv[i] = *(const v4u*)(VB + (row0 + c * 64 + row) * AW + h * 128 + c16 * 8); }
#pragma unroll
        for (int i = 0; i < 2; ++i) { const int p = tid + 512 * i, row = p >> 4, c16 = p & 15;
            *(LAS v4u*)(lds + tr_off(row, c16)) = scale8(kv[i], wts[c * 64 + row]); *(LAS v4u*)(lds + 16384 + tr_off(row, c16)) = vv[i]; }
        __syncthreads();
#pragma unroll
        for (int ks = 0; ks < 4; ++ks) {
            const bf16x8 af = trfrag(lds + kb * 4096 + ks * 1024 + trb);
#pragma unroll
            for (int vi = 0; vi < 2; ++vi) { const bf16x8 bfr = trfrag(lds + 16384 + (vb0 + vi) * 4096 + ks * 1024 + trb);
                acc[vi] = __builtin_amdgcn_mfma_f32_32x32x16_bf16(af, bfr, acc[vi], 0, 0, 0); }
        }
        if (tid < 128) {
            const int k = tid; float s = 0.f;
#pragma unroll 8
            for (int sidx = 0; sidx < 64; ++sidx) { const unsigned short w = *(const LAS unsigned short*)(lds + (k >> 5) * 4096 + (sidx >> 4) * 1024 + (sidx & 15) * 64 + (k & 31) * 2); s += __builtin_bit_cast(float, (unsigned)w << 16); }
            nsum += s;
        }
        __syncthreads();
    }
    float* U = (float*)(F.ws + WS_SCU) + (size_t)item * 16384;
#pragma unroll
    for (int vi = 0; vi < 2; ++vi) { const int v = 32 * (vb0 + vi) + r32;
#pragma unroll
        for (int g4 = 0; g4 < 4; ++g4) *(f32x4*)(U + v * 128 + 32 * kb + 8 * g4 + 4 * hi) = (f32x4){acc[vi][4 * g4], acc[vi][4 * g4 + 1], acc[vi][4 * g4 + 2], acc[vi][4 * g4 + 3]}; }
    if (tid < 128) ((float*)(F.ws + WS_SCNU))[item * 128 + tid] = nsum;
    if (tid == 0) { ((float*)(F.ws + WS_SCML))[item] = mloc; ((float*)(F.ws + WS_SCBS))[item] = btot; }
    __syncthreads();
}

__device__ __forceinline__ void p3_scan(Frame& F, const float* bff1) {
    const int gid = F.vcu * 512 + F.tid, NT = F.G * 512;
    const float* U = (const float*)(F.ws + WS_SCU); const float* NU = (const float*)(F.ws + WS_SCNU);
    const float* ML = (const float*)(F.ws + WS_SCML); const float* BS = (const float*)(F.ws + WS_SCBS);
    float* STC = (float*)(F.ws + WS_STC); float* STN = (float*)(F.ws + WS_STN); float* STM = (float*)(F.ws + WS_STM);
    for (int e = gid; e < 8 * 16384 + 8 * 128; e += NT) {
        const bool isn = e >= 8 * 16384; const int ee = isn ? e - 8 * 16384 : e;
        const int seq = isn ? (ee >> 7) : (ee >> 14), el = isn ? (ee & 127) : (ee & 16383);
        float u[31];
#pragma unroll
        for (int j = 0; j < 31; ++j) u[j] = isn ? NU[(seq * 32 + j) * 128 + el] : U[(size_t)(seq * 32 + j) * 16384 + el];
        float c = 0.f, m = 0.f;
#pragma unroll
        for (int j = 0; j < 32; ++j) {
            if (isn) STN[(seq * 32 + j) * 128 + el] = c; else STC[(size_t)(seq * 32 + j) * 16384 + el] = c;
            if (el == 0 && !isn) STM[seq * 32 + j] = m;
            if (j < 31) { const float bsj = BS[seq * 32 + j], mlj = ML[seq * 32 + j]; const float mn = fmaxf(bsj + m, mlj);
                c = __expf(bsj + m - mn) * c + __expf(mlj - mn) * u[j]; m = mn; }
        }
    }
    const float* C1P = (const float*)(F.ws + WS_C1P); const float* C2P = (const float*)(F.ws + WS_C2P);
    float* C1 = (float*)(F.ws + WS_C1); float* C2 = (float*)(F.ws + WS_C2);
    for (int n = gid; n < FF; n += NT) { float s1 = 0.f, s2 = 0.f;
#pragma unroll
        for (int kb = 0; kb < 16; ++kb) { s1 += C1P[kb * FF + n]; s2 += C2P[kb * FF + n]; }
        C1[n] = s1; C2[n] = s2 + bff1[n]; }
}

constexpr int M3_Q = 0, M3_K = 16384, M3_V = 32768, M3_KW = 49152, M3_C = 65536, M3_S = 98304, M3_H = 0;
__device__ __forceinline__ void mlstm_stage3_item(Frame& F, const Args& A, int item) {
    const int tid = F.tid, lane = F.lane, wid = F.wave, r32 = lane & 31, hi = lane >> 5;
    const bf16* QB = (const bf16*)(F.ws + WS_QB); const bf16* KB = (const bf16*)(F.ws + WS_KB); const bf16* VB = (const bf16*)(F.ws + WS_VB); const bf16* OG = (const bf16*)(F.ws + WS_OG);
    const float* IG = (const float*)(F.ws + WS_IG); const float* LFp = (const float*)(F.ws + WS_LF);
    bf16* MIX = (bf16*)(F.ws + WS_MIX);
    const float* gn = A.in[10];
    int h, nch; long row0; const float* C0; const float* N0; float m0; bool zero_init = false;
    float* Cout; float* Nout; float* Mout; bool last;
    if (item < 256) {
        const int seq = item >> 5, j = item & 31, b = seq >> 2; h = seq & 3; row0 = (long)b * SEQ + (long)j * 512; nch = 8;
        C0 = (const float*)(F.ws + WS_STC) + (size_t)item * 16384; N0 = (const float*)(F.ws + WS_STN) + item * 128; m0 = ((const float*)(F.ws + WS_STM))[item];
        zero_init = (j == 0); last = (j == 31);
        Cout = F.out + O_CP + (size_t)seq * 16384; Nout = F.out + O_NP + seq * 128; Mout = F.out + O_MP + seq;
    } else {
        const int s = item - 256, db = s >> 2; h = s & 3; row0 = MP + (long)db * 64; nch = 1;
        C0 = A.in[4] + (size_t)s * 16384; N0 = A.in[5] + s * 128; m0 = A.in[6][s]; last = true;
        Cout = F.out + O_CS + (size_t)s * 16384; Nout = F.out + O_NS + s * 128; Mout = F.out + O_MS + s;
    }
    LAS unsigned char* lds = F.lds;
    LAS float* sa = (LAS float*)(lds + M3_S);
    LAS float* smu = sa + 64; LAS float* sg = sa + 128; LAS float* swe = sa + 192; LAS float* senm = sa + 256;
    LAS float* srs = sa + 320; LAS float* snq = sa + 384; LAS float* sinv = sa + 448; LAS float* sn = sa + 512;
    LAS float* sdec = sa + 640;
    const int kb = wid >> 1, vb0 = 2 * (wid & 1);
    const int th = wid >> 2, vq = wid & 3;
    const int trb = tr_read_base(lane);
    f32x16 cacc[2];
#pragma unroll
    for (int vi = 0; vi < 2; ++vi) { const int v = 32 * (vb0 + vi) + r32;
#pragma unroll
        for (int g4 = 0; g4 < 4; ++g4) { f32x4 x = (f32x4){0.f, 0.f, 0.f, 0.f}; if (!zero_init) x = *(const f32x4*)(C0 + v * 128 + 32 * kb + 8 * g4 + 4 * hi);
            cacc[vi][4 * g4] = x[0]; cacc[vi][4 * g4 + 1] = x[1]; cacc[vi][4 * g4 + 2] = x[2]; cacc[vi][4 * g4 + 3] = x[3];
            *(LAS v2u*)(lds + M3_C + (4 * kb + g4) * 2048 + v * 16 + hi * 8) = (v2u){pk2(x[0], x[1]), pk2(x[2], x[3])}; } }
    if (tid < 128) sn[tid] = zero_init ? 0.f : N0[tid];
    float mrun = zero_init ? 0.f : m0;
    __syncthreads();
    for (int c = 0; c < nch; ++c) {
        const long rowc = row0 + c * 64;
        v4u qv[2], kv[2], vv[2];
#pragma unroll
        for (int i = 0; i < 2; ++i) { const int p = tid + 512 * i, row = p >> 4, c16 = p & 15; const size_t off = (size_t)(rowc + row) * AW + h * 128 + c16 * 8;
            qv[i] = *(const v4u*)(QB + off); kv[i] = *(const v4u*)(KB + off); vv[i] = *(const v4u*)(VB + off); }
        if (wid == 0) {
            const float lfv = LFp[(rowc + lane) * 4 + h], igv = IG[(rowc + lane) * 4 + h];
            float bs = lfv;
#pragma unroll
            for (int off = 1; off < 64; off <<= 1) { const float t = __shfl_up(bs, off); if (lane >= off) bs += t; }
            const float a = igv - bs;
            float pm = a;
#pragma unroll
            for (int off = 1; off < 64; off <<= 1) { const float t = __shfl_up(pm, off); if (lane >= off) pm = fmaxf(pm, t); }
            const float mu = fmaxf(mrun, pm), g = __expf(mrun - mu);
            const float muL = __shfl(mu, 63), bL = __shfl(bs, 63);
            sa[lane] = a; smu[lane] = mu; sg[lane] = g; swe[lane] = __expf(a - muL); senm[lane] = __expf(-(bs + mu));
            if (lane == 0) sdec[0] = __expf(mrun - muL);
            mrun = bL + muL;
        }
#pragma unroll
        for (int i = 0; i < 2; ++i) { const int p = tid + 512 * i, row = p >> 4, c16 = p & 15;
            *(LAS v4u*)(lds + M3_Q + c16 * 1024 + row * 16) = qv[i]; *(LAS v4u*)(lds + M3_K + c16 * 1024 + row * 16) = kv[i]; *(LAS v4u*)(lds + M3_V + tr_off(row, c16)) = vv[i]; }
        __syncthreads();
#pragma unroll
        for (int i = 0; i < 2; ++i) { const int p = tid + 512 * i, row = p >> 4, c16 = p & 15; *(LAS v4u*)(lds + M3_KW + tr_off(row, c16)) = scale8(kv[i], swe[row]); }
        { const int t = tid >> 3, part = tid & 7; float s = 0.f;
#pragma unroll
          for (int cc = 0; cc < 2; ++cc) { const int ch = 2 * part + cc; const v4u q8 = *(const LAS v4u*)(lds + M3_Q + ch * 1024 + t * 16);
              const f32x4 n0 = *(const LAS f32x4*)(sn + ch * 8), n1 = *(const LAS f32x4*)(sn + ch * 8 + 4);
              s += bflo(q8.x) * n0[0] + bfhi(q8.x) * n0[1] + bflo(q8.y) * n0[2] + bfhi(q8.y) * n0[3] + bflo(q8.z) * n1[0] + bfhi(q8.z) * n1[1] + bflo(q8.w) * n1[2] + bfhi(q8.w) * n1[3]; }
          s += __shfl_xor(s, 1); s += __shfl_xor(s, 2); s += __shfl_xor(s, 4);
          if (part == 0) snq[t] = s; }
        bf16x8 qf[8];
#pragma unroll
        for (int d0 = 0; d0 < 8; ++d0) qf[d0] = *(const LAS bf16x8*)(lds + M3_Q + (2 * d0 + hi) * 1024 + (32 * th + r32) * 16);
        v4u pw[4]; float rs = 0.f;
        const int tt = 32 * th + r32; const float mut = smu[tt];
#pragma unroll
        for (int sh = 0; sh < 2; ++sh) {
            f32x16 p;
#pragma unroll
            for (int r = 0; r < 16; ++r) p[r] = 0.f;
#pragma unroll
            for (int d0 = 0; d0 < 8; ++d0) { const bf16x8 kf = *(const LAS bf16x8*)(lds + M3_K + (2 * d0 + hi) * 1024 + (32 * sh + r32) * 16);
                p = __builtin_amdgcn_mfma_f32_32x32x16_bf16(kf, qf[d0], p, 0, 0, 0); }
#pragma unroll
            for (int g4 = 0; g4 < 4; ++g4) { const f32x4 av = *(const LAS f32x4*)(sa + 32 * sh + 8 * g4 + 4 * hi);
#pragma unroll
                for (int e = 0; e < 4; ++e) { const int s = 32 * sh + 8 * g4 + 4 * hi + e; const float w = (s <= tt) ? __expf(av[e] - mut) : 0.f; const float x = p[4 * g4 + e] * w; p[4 * g4 + e] = x; rs += x; } }
            pw[2 * sh] = (v4u){cvt_pk_bf16(p[0], p[1]), cvt_pk_bf16(p[2], p[3]), cvt_pk_bf16(p[4], p[5]), cvt_pk_bf16(p[6], p[7])};
            pw[2 * sh + 1] = (v4u){cvt_pk_bf16(p[8], p[9]), cvt_pk_bf16(p[10], p[11]), cvt_pk_bf16(p[12], p[13]), cvt_pk_bf16(p[14], p[15])};
        }
        rs = swap_add(rs);
        if (vq == 0 && hi == 0) srs[tt] = rs;
        f32x16 num;
#pragma unroll
        for (int r = 0; r < 16; ++r) num[r] = 0.f;
#pragma unroll
        for (int d0 = 0; d0 < 8; ++d0) { const bf16x8 cf = *(const LAS bf16x8*)(lds + M3_C + (2 * d0 + hi) * 2048 + (32 * vq + r32) * 16);
            num = __builtin_amdgcn_mfma_f32_32x32x16_bf16(qf[d0], cf, num, 0, 0, 0); }
#pragma unroll
        for (int g4 = 0; g4 < 4; ++g4) { const f32x4 gv = *(const LAS f32x4*)(sg + 32 * th + 8 * g4 + 4 * hi);
#pragma unroll
            for (int e = 0; e < 4; ++e) num[4 * g4 + e] *= gv[e]; }
#pragma unroll
        for (int ks = 0; ks < 4; ++ks) { const bf16x8 vf = trfrag(lds + M3_V + vq * 4096 + ks * 1024 + trb);
            num = __builtin_amdgcn_mfma_f32_32x32x16_bf16(__builtin_bit_cast(bf16x8, pw[ks]), vf, num, 0, 0, 0); }
        __syncthreads();
        if (tid < 64) { const float den = sg[tid] * snq[tid] + srs[tid]; sinv[tid] = 1.0f / fmaxf(fabsf(den), senm[tid]); }
        const float decay = sdec[0];
#pragma unroll
        for (int vi = 0; vi < 2; ++vi)
#pragma unroll
            for (int r = 0; r < 16; ++r) cacc[vi][r] *= decay;
#pragma unroll
        for (int ks = 0; ks < 4; ++ks) { const bf16x8 af = trfrag(lds + M3_KW + kb * 4096 + ks * 1024 + trb);
#pragma unroll
            for (int vi = 0; vi < 2; ++vi) { const bf16x8 bfr = trfrag(lds + M3_V + (vb0 + vi) * 4096 + ks * 1024 + trb);
                cacc[vi] = __builtin_amdgcn_mfma_f32_32x32x16_bf16(af, bfr, cacc[vi], 0, 0, 0); } }
        if (tid < 128) { const int k = tid; float s = 0.f;
#pragma unroll 8
            for (int sidx = 0; sidx < 64; ++sidx) { const unsigned short w = *(const LAS unsigned short*)(lds + M3_KW + (k >> 5) * 4096 + (sidx >> 4) * 1024 + (sidx & 15) * 64 + (k & 31) * 2); s += __builtin_bit_cast(float, (unsigned)w << 16); }
            sn[k] = decay * sn[k] + s; }
        __syncthreads();
#pragma unroll
        for (int g4 = 0; g4 < 4; ++g4) { const f32x4 iv = *(const LAS f32x4*)(sinv + 32 * th + 8 * g4 + 4 * hi);
#pragma unroll
            for (int e = 0; e < 4; ++e) { const int t = 32 * th + 8 * g4 + 4 * hi + e; *(LAS float*)(lds + M3_H + (t * 128 + 32 * vq + r32) * 4) = num[4 * g4 + e] * iv[e]; } }
#pragma unroll
        for (int vi = 0; vi < 2; ++vi) { const int v = 32 * (vb0 + vi) + r32;
#pragma unroll
            for (int g4 = 0; g4 < 4; ++g4) *(LAS v2u*)(lds + M3_C + (4 * kb + g4) * 2048 + v * 16 + hi * 8) = (v2u){pk2(cacc[vi][4 * g4], cacc[vi][4 * g4 + 1]), pk2(cacc[vi][4 * g4 + 2], cacc[vi][4 * g4 + 3])}; }
        __syncthreads();
        { const int t = tid >> 3, part = tid & 7; f32x4 x[4]; float s = 0.f;
#pragma unroll
          for (int i = 0; i < 4; ++i) { x[i] = *(const LAS f32x4*)(lds + M3_H + (t * 128 + part * 16 + 4 * i) * 4); s += (x[i][0] + x[i][1]) + (x[i][2] + x[i][3]); }
          s += __shfl_xor(s, 1); s += __shfl_xor(s, 2); s += __shfl_xor(s, 4);
          const float mean = s * (1.f / 128.f); float q = 0.f;
#pragma unroll
          for (int i = 0; i < 4; ++i) { x[i] = x[i] - mean; q += (x[i][0] * x[i][0] + x[i][1] * x[i][1]) + (x[i][2] * x[i][2] + x[i][3] * x[i][3]); }
          q += __shfl_xor(q, 1); q += __shfl_xor(q, 2); q += __shfl_xor(q, 4);
          const float rstd = 1.0f / sqrtf(q * (1.f / 128.f) + LN_EPS);
          const size_t orow = (size_t)(rowc + t);
          const v4u og0 = *(const v4u*)(OG + orow * AW + h * 128 + part * 16), og1 = *(const v4u*)(OG + orow * AW + h * 128 + part * 16 + 8);
          const float* gp = gn + h * 128 + part * 16;
          const f32x4 g0 = *(const f32x4*)gp, g1 = *(const f32x4*)(gp + 4), g2 = *(const f32x4*)(gp + 8), g3 = *(const f32x4*)(gp + 12);
          v4u o0, o1;
          o0.x = pk2(x[0][0] * rstd * g0[0] * bflo(og0.x), x[0][1] * rstd * g0[1] * bfhi(og0.x)); o0.y = pk2(x[0][2] * rstd * g0[2] * bflo(og0.y), x[0][3] * rstd * g0[3] * bfhi(og0.y));
          o0.z = pk2(x[1][0] * rstd * g1[0] * bflo(og0.z), x[1][1] * rstd * g1[1] * bfhi(og0.z)); o0.w = pk2(x[1][2] * rstd * g1[2] * bflo(og0.w), x[1][3] * rstd * g1[3] * bfhi(og0.w));
          o1.x = pk2(x[2][0] * rstd * g2[0] * bflo(og1.x), x[2][1] * rstd * g2[1] * bfhi(og1.x)); o1.y = pk2(x[2][2] * rstd * g2[2] * bflo(og1.y), x[2][3] * rstd * g2[3] * bfhi(og1.y));
          o1.z = pk2(x[3][0] * rstd * g3[0] * bflo(og1.z), x[3][1] * rstd * g3[1] * bfhi(og1.z)); o1.w = pk2(x[3][2] * rstd * g3[2] * bflo(og1.w), x[3][3] * rstd * g3[3] * bfhi(og1.w));
          bf16* mp = MIX + orow * DM + 512 + h * 128 + part * 16;
          *(v4u*)mp = o0; *(v4u*)(mp + 8) = o1; }
        __syncthreads();
    }
    if (last) {
#pragma unroll
        for (int vi = 0; vi < 2; ++vi) { const int v = 32 * (vb0 + vi) + r32;
#pragma unroll
            for (int g4 = 0; g4 < 4; ++g4) *(f32x4*)(Cout + v * 128 + 32 * kb + 8 * g4 + 4 * hi) = (f32x4){cacc[vi][4 * g4], cacc[vi][4 * g4 + 1], cacc[vi][4 * g4 + 2], cacc[vi][4 * g4 + 3]}; }
        if (tid < 128) Nout[tid] = sn[tid];
        if (tid == 0) Mout[0] = mrun;
    }
    __syncthreads();
}

__device__ __forceinline__ void p8_final_ln(Frame& F, const float* g2, const float* b2) {
    const int gw = F.vcu * 8 + F.wave, NGW = F.G * 8;
    f32x4 gg[4], bb[4];
#pragma unroll
    for (int j = 0; j < 4; ++j) { gg[j] = *(const f32x4*)(g2 + 256 * j + 4 * F.lane); bb[j] = *(const f32x4*)(b2 + 256 * j + 4 * F.lane); }
    for (int m = gw; m < MT; m += NGW) {
        GAS f32x4* xr = (GAS f32x4*)(F.out + (size_t)m * DM) + F.lane;
        f32x4 v[4]; float s = 0.f;
#pragma unroll
        for (int j = 0; j < 4; ++j) { v[j] = xr[64 * j]; s += (v[j][0] + v[j][1]) + (v[j][2] + v[j][3]); }
        const float mean = wave_sum(s) * (1.f / DM); float s2 = 0.f;
#pragma unroll
        for (int j = 0; j < 4; ++j) { v[j] = v[j] - mean; s2 += (v[j][0] * v[j][0] + v[j][1] * v[j][1]) + (v[j][2] * v[j][2] + v[j][3] * v[j][3]); }
        const float rstd = 1.f / sqrtf(wave_sum(s2) * (1.f / DM) + LN_EPS);
#pragma unroll
        for (int j = 0; j < 4; ++j) xr[64 * j] = v[j] * rstd * gg[j] + bb[j];
    }
}

#define XB_TMO      128
#define XB_XCNT(j)  (256  + 64 * (j))
#define XB_XSUB(j)  (1280 + 64 * (j))
#define XB_XGEN(j)  (2304 + 64 * (j))
#define XB_TOP      3328
#define XB_TOPGEN   3392
#define XCD_BAR_WORDS 3456
#define XB_SPIN_CAP (1u << 18)
__device__ __forceinline__ unsigned xb_ld(unsigned* p)              { return __hip_atomic_load(p, __ATOMIC_RELAXED, __HIP_MEMORY_SCOPE_AGENT); }
__device__ __forceinline__ unsigned xb_add(unsigned* p, unsigned v) { return __hip_atomic_fetch_add(p, v, __ATOMIC_RELAXED, __HIP_MEMORY_SCOPE_AGENT); }
__device__ __forceinline__ unsigned xb_xcc_id() { return (unsigned)__builtin_amdgcn_s_getreg((3 << 11) | 20) & 0xFu; }
#define XB_SPIN(cond, bar) do { unsigned _sp = 0; while (cond) { __builtin_amdgcn_s_sleep(1); \
    if ((++_sp & 255u) == 0u) { if (xb_ld(&(bar)[XB_TMO])) break; if (_sp > XB_SPIN_CAP) { atomicAdd(&(bar)[XB_TMO], 1u); break; } } } } while (0)
struct XcdBarrier { unsigned* bar; unsigned x; volatile LAS unsigned* st; };
__device__ __forceinline__ XcdBarrier xcd_barrier_post(unsigned* bar, volatile LAS unsigned* st) {
    XcdBarrier b; b.bar = bar; b.x = xb_xcc_id(); b.st = st;
    if (threadIdx.x == 0) (void)xb_add(&bar[XB_XCNT(b.x)], 1u);
    return b;
}
__device__ __forceinline__ void xcd_barrier_complete(unsigned* bar, unsigned x, unsigned& nloc, unsigned& nx) {
    const unsigned G = gridDim.x * gridDim.y * gridDim.z;
    unsigned sum, cnt, mine, sp = 0u;
    for (;;) {
        sum = 0u; cnt = 0u; mine = 0u;
#pragma unroll
        for (unsigned j = 0; j < 16; ++j) { const unsigned c = xb_ld(&bar[XB_XCNT(j)]); sum += c; cnt += (c > 0u) ? 1u : 0u; mine = (j == x) ? c : mine; }
        if (sum == G) break;
        __builtin_amdgcn_s_sleep(1);
        if ((++sp & 255u) == 0u) { if (xb_ld(&bar[XB_TMO])) break; if (sp > XB_SPIN_CAP) { atomicAdd(&bar[XB_TMO], 1u); break; } }
    }
    nloc = mine > 0u ? mine : 1u; nx = cnt > 0u ? cnt : 1u;
}
__device__ __forceinline__ void xcd_barrier(const XcdBarrier& b) {
    asm volatile("s_waitcnt vmcnt(0)" ::: "memory");
    __syncthreads();
    if (threadIdx.x == 0) {
        unsigned* bar = b.bar;
        __builtin_amdgcn_s_waitcnt(0);
        unsigned nloc = b.st[0], nx = b.st[1];
        if (nloc == 0u) { xcd_barrier_complete(bar, b.x, nloc, nx); b.st[0] = nloc; b.st[1] = nx; }
        const unsigned old = xb_add(&bar[XB_XSUB(b.x)], 1u);
        const unsigned gen = old / nloc;
        if (old + 1u == (gen + 1u) * nloc) {
            __builtin_amdgcn_fence(__ATOMIC_RELEASE, "agent");
            asm volatile("s_waitcnt vmcnt(0)" ::: "memory");
            const unsigned og = xb_add(&bar[XB_TOP], 1u);
            const unsigned tg = og / nx;
            if (og + 1u == (tg + 1u) * nx) xb_add(&bar[XB_TOPGEN], 1u);
            else XB_SPIN(xb_ld(&bar[XB_TOPGEN]) == tg, bar);
            __builtin_amdgcn_fence(__ATOMIC_ACQUIRE, "agent");
            xb_add(&bar[XB_XGEN(b.x)], 1u);
            asm volatile("s_waitcnt vmcnt(0)" ::: "memory");
        } else {
            XB_SPIN(xb_ld(&bar[XB_XGEN(b.x)]) == gen, bar);
            __builtin_amdgcn_fence(__ATOMIC_ACQUIRE, "agent");
            asm volatile("s_waitcnt vmcnt(0)" ::: "memory");
        }
    }
    __syncthreads();
}

constexpr int N_PHASES = 9;

__global__ void __launch_bounds__(512, 2) hybrid_fwd(Args args) {
    extern __shared__ __attribute__((aligned(16))) unsigned char lds_raw[];
    Frame F;
    F.lds = (LAS unsigned char*)lds_raw;
    F.tid = threadIdx.x; F.lane = F.tid & 63; F.wave = __builtin_amdgcn_readfirstlane(F.tid >> 6);
    F.G = gridDim.x; { const int bx = blockIdx.x; F.vcu = (F.G % 8 == 0) ? (bx % 8) * (F.G / 8) + bx / 8 : bx; }
    F.out = args.out; F.ws = args.ws;
    const int lo = args.ph_lo, hi = args.ph_hi;
#define IN(k) (lo <= (k) && (k) < hi)
#define BOTH(k) (IN(k) && IN((k) + 1))
#define GRID_BAR() do { xcd_barrier(bar); if (DUP_PHASE == 99) xcd_barrier(bar); } while (0)
    for (int u = F.tid; u < (LDS_BYTES - RING_BYTES) / 4; u += 512) ((LAS unsigned*)(F.lds + RING_BYTES))[u] = 0u;
    __syncthreads();
    XcdBarrier bar; bar.bar = (unsigned*)(F.ws + WS_CTL) + CW_BAR; bar.x = 0; bar.st = nullptr;
    if (hi - lo > 1) bar = xcd_barrier_post((unsigned*)(F.ws + WS_CTL) + CW_BAR, (volatile LAS unsigned*)(F.lds + MISC_OFF) + 8);

    if (IN(0)) { p0_prologue(F, args); if (DUP_PHASE == 10) { __syncthreads(); p0_prologue(F, args); } if (BOTH(0)) GRID_BAR(); }

    if (IN(1)) {
        pg8::Gemm g{(const bf16*)(F.ws + WS_XB), (const bf16*)(F.ws + WS_WIN), MT, NIN, DM}; pg8::StaticOrder S; S.init(MT, NIN, F.G, (int)blockIdx.x);
        EpiInProj E; E.ws = F.ws; E.bias = args.in[8];
        static_assert(WS_KA == WS_QA + 33 * MiB && WS_VA == WS_QA + 70 * MiB && WS_QB == WS_QA + 107 * MiB && WS_KB == WS_QA + 140 * MiB && WS_VB == WS_QA + 173 * MiB && WS_OG == WS_QA + 206 * MiB, "slice map");
        E.out = F.out;
        pg8::gemm_phase<EpiInProj, pg8::StaticOrder, true, true>(F.lds, g, S, E);
        if (DUP_PHASE == 1) pg8::gemm_phase<EpiInProj, pg8::StaticOrder, true, true>(F.lds, g, S, E);
        if (BOTH(1)) GRID_BAR();
    }

    if (IN(2)) {
        const bf16* QA = (const bf16*)(F.ws + WS_QA); const bf16* KA = (const bf16*)(F.ws + WS_KA); const bf16* VA = (const bf16*)(F.ws + WS_VA); bf16* MIX = (bf16*)(F.ws + WS_MIX);
        for (int rep = 0; rep < (DUP_PHASE == 20 ? 2 : 1); ++rep) {
        for (int id = F.vcu * 4; id < 1024; id += F.G * 4)
            for (int k = 0; k < 4; ++k) { const int uid = id + k, bh = uid >> 6, qb = uid & 63, b = bh >> 3, h = bh & 7;
                const int ilo = (8 - 4 * qb) > 0 ? (8 - 4 * qb) : 0;
                attn_unit(F, QA, KA, VA, MIX, args.in[9], h, (long)b * SEQ + 256 * qb, (long)b * SEQ + 64 * (4 * qb - 8), ilo, 11, 8); }
        for (int uid = F.vcu; uid < 64; uid += F.G) { const int db = uid >> 3, h = uid & 7;
            attn_unit(F, QA, KA, VA, MIX, args.in[9], h, (long)MP + 64 * db, (long)MP + 576 * db, 0, 8, 2); }
        }
        for (int rep = 0; rep < (DUP_PHASE == 21 ? 2 : 1); ++rep)
        for (int it = F.vcu; it < 256; it += F.G) mlstm_stage1_item(F, it);
        if (BOTH(2)) GRID_BAR();
    }

    if (IN(3)) { p3_scan(F, args.in[15]); if (DUP_PHASE == 3) p3_scan(F, args.in[15]); if (BOTH(3)) GRID_BAR(); }

    if (IN(4)) { for (int rep = 0; rep < (DUP_PHASE == 4 ? 2 : 1); ++rep) for (int it = F.vcu; it < 288; it += F.G) mlstm_stage3_item(F, args, it); if (BOTH(4)) GRID_BAR(); }

    if (IN(5)) {
        pg8::Gemm g{(const bf16*)(F.ws + WS_MIX), (const bf16*)(F.ws + WS_WOUT), MT, DM, DM}; pg8::StaticOrder S; S.init(MT, DM, F.G, (int)blockIdx.x);
        EpiZ1 E{args.in[0], args.in[1], (bf16*)(F.ws + WS_Z1), (float*)(F.ws + WS_STAT1), true};
        pg8::gemm_phase<EpiZ1, pg8::StaticOrder, true, true>(F.lds, g, S, E);
        if (DUP_PHASE == 5) { E.do_stat = false; pg8::gemm_phase<EpiZ1, pg8::StaticOrder, true, true>(F.lds, g, S, E); }
        if (BOTH(5)) GRID_BAR();
    }

    if (IN(6)) {
        pg8::Gemm g{(const bf16*)(F.ws + WS_Z1), (const bf16*)(F.ws + WS_W1), MT, FF, DM}; pg8::StaticOrder S; S.init(MT, FF, F.G, (int)blockIdx.x);
        EpiFfn1 E{(const float*)(F.ws + WS_STAT1), (const float*)(F.ws + WS_C1), (const float*)(F.ws + WS_C2), (bf16*)(F.ws + WS_HID)};
        pg8::gemm_phase<EpiFfn1, pg8::StaticOrder, true, true>(F.lds, g, S, E);
        if (DUP_PHASE == 6) pg8::gemm_phase<EpiFfn1, pg8::StaticOrder, true, true>(F.lds, g, S, E);
        if (BOTH(6)) GRID_BAR();
    }

    if (IN(7)) {
        pg8::Gemm g{(const bf16*)(F.ws + WS_HID), (const bf16*)(F.ws + WS_W2), MT, DM, FF}; pg8::StaticOrder S; S.init(MT, DM, F.G, (int)blockIdx.x);
        EpiFfn2 E{(const float*)(F.ws + WS_STAT1), (const bf16*)(F.ws + WS_Z1), args.in[12], args.in[13], args.in[17], F.out};
        pg8::gemm_phase<EpiFfn2, pg8::StaticOrder, true, true>(F.lds, g, S, E);
        if (DUP_PHASE == 7) pg8::gemm_phase<EpiFfn2, pg8::StaticOrder, true, true>(F.lds, g, S, E);
        if (BOTH(7)) GRID_BAR();
    }

    if (IN(8)) { p8_final_ln(F, args.in[18], args.in[19]); }
#undef IN
#undef BOTH
#undef GRID_BAR
}

extern "C" void kernel_launch(void* const* d_in, const int* in_sizes, int n_in, void* d_out, int out_size, void* d_ws, size_t ws_size, hipStream_t stream) {
    static int grid = 0;
    if (grid == 0) {
        if (n_in != 20 || out_size != (int)O_END || ws_size < WS_END) { fprintf(stderr, "kernel_launch: unexpected shapes: n_in %d out %d ws %zu (need %zu)\n", n_in, out_size, ws_size, (size_t)WS_END); grid = -1; return; }
        int dev = 0, cus = 0, per_cu = 0;
        if (hipGetDevice(&dev) != hipSuccess || hipDeviceGetAttribute(&cus, hipDeviceAttributeMultiprocessorCount, dev) != hipSuccess) { grid = -1; return; }
        if (hipFuncSetAttribute((const void*)hybrid_fwd, hipFuncAttributeMaxDynamicSharedMemorySize, LDS_BYTES) != hipSuccess) { fprintf(stderr, "kernel_launch: hipFuncSetAttribute failed\n"); grid = -1; return; }
        if (hipOccupancyMaxActiveBlocksPerMultiprocessor(&per_cu, (const void*)hybrid_fwd, 512, LDS_BYTES) != hipSuccess || per_cu < 1) { fprintf(stderr, "kernel_launch: occupancy query says %d\n", per_cu); (void)hipGetLastError(); grid = -1; return; }
        grid = cus;
    }
    if (grid < 0) return;
    if (hipMemsetAsync((char*)d_ws + WS_CTL, 0, CTL_ZERO_BYTES, stream) != hipSuccess) { fprintf(stderr, "kernel_launch: hipMemsetAsync failed\n"); return; }
    Args a{};
    for (int i = 0; i < 20; ++i) a.in[i] = (const float*)d_in[i];
    a.out = (float*)d_out; a.ws = (unsigned char*)d_ws;
#if MK_N_LAUNCHES == 1
    a.ph_lo = 0; a.ph_hi = N_PHASES; a.coop = 1;
    void* kargs[] = {&a};
    hipError_t e = hipLaunchCooperativeKernel((const void*)hybrid_fwd, dim3(grid), dim3(512), kargs, LDS_BYTES, stream);
    if (e != hipSuccess) fprintf(stderr, "kernel_launch: cooperative launch failed: %s (grid %d)\n", hipGetErrorString(e), grid);
#else
    for (int p = 0; p < N_PHASES; ++p) {
        a.ph_lo = p; a.ph_hi = p + 1; a.coop = 0;
        hipLaunchKernelGGL(hybrid_fwd, dim3(grid), dim3(512), LDS_BYTES, stream, a);
    }
#endif
}
```

```cpp
#include <hip/hip_runtime.h>
#include <hip/hip_cooperative_groups.h>
#include <cstdio>
#include <cstdint>
namespace cg = cooperative_groups;

#ifndef MK_N_LAUNCHES
#define MK_N_LAUNCHES 1
#endif
#ifndef DUP_PHASE
#define DUP_PHASE 0
#endif

constexpr int DM = 1024, SEQ = 16384, NB = 2, DB = 8, DSEQ = 64;
constexpr int MP = NB * SEQ;
constexpr int MS = DB * DSEQ;
constexpr int MT = MP + MS;
constexpr int INW = 3592, NIN = 3584;
constexpr int AW = 512;
constexpr int FF = 4096;
constexpr int KVROWS = MP + DB * 576;
constexpr float LN_EPS = 1e-5f;
constexpr float ALPHA = 1.189207115002721f;
constexpr float LOG2E = 1.4426950408889634f;
constexpr float QSCALE = 0.125f * LOG2E;
constexpr float KBSCALE = 0.08838834764831845f;
constexpr size_t O_YP = 0, O_YS = 33554432, O_KP = 34078720, O_VP = 34603008, O_CP = 35127296, O_NP = 35258368, O_MP = 35259392,
                 O_KS = 35259400, O_VS = 35521544, O_CS = 35783688, O_NS = 36307976, O_MS = 36312072, O_END = 36312104;

constexpr size_t MiB = 1u << 20, KiB = 1024;
constexpr size_t WS_CTL = 0, CTL_ZERO_BYTES = 1 * MiB;
constexpr size_t WS_IG = 1 * MiB;
constexpr size_t WS_LF = 1 * MiB + 768 * KiB;
constexpr size_t WS_STAT1 = 2 * MiB + 512 * KiB;
constexpr size_t WS_C1P = 3 * MiB;
constexpr size_t WS_C2P = 3 * MiB + 256 * KiB;
constexpr size_t WS_C1 = 3 * MiB + 512 * KiB;
constexpr size_t WS_C2 = 3 * MiB + 528 * KiB;
constexpr size_t WS_SCNU = 3 * MiB + 768 * KiB;
constexpr size_t WS_STN = 3 * MiB + 896 * KiB;
constexpr size_t WS_SCML = 4 * MiB;
constexpr size_t WS_SCBS = 4 * MiB + 4 * KiB;
constexpr size_t WS_STM = 4 * MiB + 8 * KiB;
constexpr size_t WS_SCU = 5 * MiB;
constexpr size_t WS_STC = 21 * MiB;
constexpr size_t WS_WIN = 37 * MiB, WS_WOUT = 44 * MiB, WS_W1 = 46 * MiB, WS_W2 = 54 * MiB;
constexpr size_t WS_XB = 62 * MiB;
constexpr size_t WS_QA = 127 * MiB;
constexpr size_t WS_KA = WS_QA + 33 * MiB;
constexpr size_t WS_VA = WS_KA + 37 * MiB;
constexpr size_t WS_QB = WS_VA + 37 * MiB;
constexpr size_t WS_KB = WS_QB + 33 * MiB;
constexpr size_t WS_VB = WS_KB + 33 * MiB;
constexpr size_t WS_OG = WS_VB + 33 * MiB;
constexpr size_t WS_HID = 62 * MiB;
constexpr size_t WS_MIX = WS_OG + 33 * MiB;
constexpr size_t WS_Z1 = WS_MIX + 65 * MiB;
constexpr size_t WS_END = WS_Z1 + 65 * MiB;
static_assert(WS_HID + (size_t)MT * FF * 2 <= WS_OG, "HID overlay must not reach OG/MIX");
static_assert(WS_END <= 512 * MiB, "workspace map");
constexpr int CW_BAR = 4096;

constexpr int RING_BYTES = 131072;
constexpr int MISC_OFF = RING_BYTES + 320;
constexpr int LDS_BYTES = 147456;

#define GAS __attribute__((address_space(1)))
#define LAS __attribute__((address_space(3)))
typedef unsigned short bf16;
typedef unsigned v4u __attribute__((ext_vector_type(4)));
typedef unsigned v2u __attribute__((ext_vector_type(2)));
typedef float f32x4 __attribute__((ext_vector_type(4)));
typedef float f32x2 __attribute__((ext_vector_type(2)));
typedef float f32x16 __attribute__((ext_vector_type(16)));
typedef short bf16x8 __attribute__((ext_vector_type(8)));
typedef short s16x4 __attribute__((ext_vector_type(4)));
typedef GAS unsigned gu32;
#define RLX_AGENT __ATOMIC_RELAXED, __HIP_MEMORY_SCOPE_AGENT
#define LDS_WAIT() asm volatile("s_waitcnt lgkmcnt(0)" ::: "memory")
#define VM_WAIT() asm volatile("s_waitcnt vmcnt(0)" ::: "memory")

__device__ __forceinline__ unsigned f2bf(float f) { unsigned u = __builtin_bit_cast(unsigned, f); return (u + 0x7fffu + ((u >> 16) & 1u)) >> 16; }
__device__ __forceinline__ unsigned pk2(float lo, float hi) { return f2bf(lo) | (f2bf(hi) << 16); }
__device__ __forceinline__ float bflo(unsigned w) { return __builtin_bit_cast(float, w << 16); }
__device__ __forceinline__ float bfhi(unsigned w) { return __builtin_bit_cast(float, w & 0xffff0000u); }
__device__ __forceinline__ unsigned cvt_pk_bf16(float lo, float hi) { unsigned r; asm volatile("v_cvt_pk_bf16_f32 %0, %1, %2" : "=v"(r) : "v"(lo), "v"(hi)); return r; }
__device__ __forceinline__ float wave_sum(float v) {
#pragma unroll
    for (int o = 1; o < 64; o <<= 1) v += __shfl_xor(v, o);
    return v;
}
__device__ __forceinline__ int crow(int r, int hi) { return (r & 3) + 8 * (r >> 2) + 4 * hi; }
__device__ __forceinline__ float swap_max(float m) { auto rr = __builtin_amdgcn_permlane32_swap(__float_as_uint(m), __float_as_uint(m), false, false); return fmaxf(__uint_as_float(rr[0]), __uint_as_float(rr[1])); }
__device__ __forceinline__ float swap_add(float m) { auto rr = __builtin_amdgcn_permlane32_swap(__float_as_uint(m), __float_as_uint(m), false, false); return __uint_as_float(rr[0]) + __uint_as_float(rr[1]); }
typedef short v4i16_t __attribute__((ext_vector_type(4)));
__device__ __forceinline__ s16x4 trread(LAS const unsigned char* p) { return __builtin_bit_cast(s16x4, __builtin_amdgcn_ds_read_tr16_b64_v4i16((LAS v4i16_t*)p)); }
__device__ __forceinline__ bf16x8 trfrag(LAS const unsigned char* p) { const s16x4 lo = trread(p), hi = trread(p + 512); return (bf16x8){lo[0], lo[1], lo[2], lo[3], hi[0], hi[1], hi[2], hi[3]}; }

namespace pg8 {
#define PG8_LAS __attribute__((address_space(3)))
typedef unsigned short bf16_t;
typedef unsigned u32x4 __attribute__((ext_vector_type(4)));
constexpr int BM = 256, BK = 64, HALF = 128, HTB = HALF * BK * 2, STAGE_BYTES = 8 * HTB, NXCD = 8, WGM = 8;
__host__ __device__ __forceinline__ int lds_byte(int r, int c) { const int st = (r >> 4) * 2 + (c >> 5), rr = r & 15, cc = c & 31, ob = rr * 64 + cc * 2; return st * 1024 + (ob ^ (((ob >> 9) & 1) << 5)); }
__host__ __device__ __forceinline__ void stage_rc(int b, int& R, int& C) { const int st = b / 1024, sb = b % 1024, swz = sb ^ (((sb >> 9) & 1) << 5); R = (st >> 1) * 16 + swz / 64; C = (st & 1) * 32 + (swz % 64) / 2; }
__host__ __device__ __forceinline__ int perm32(int rho) { const int n = rho >> 4, i = rho & 15; return 8 * (i >> 2) + 4 * n + (i & 3); }
struct Unit { int pm, pn; };
struct Gemm { const bf16_t* A; const bf16_t* Bt; int M, N, K; };
struct StaticOrder {
    int nM, nN, nwg, G, c;
    __host__ __device__ void init(int M, int N, int G_, int c_) { nM = M / BM; nN = N / BM; nwg = nM * nN; G = G_; c = c_; }
    __host__ __device__ bool next(int i, Unit& u) const {
        const long L = (long)i * G + c; if (L >= nwg) return false;
        int wgid = (int)L; { const int q = nwg / NXCD, r = nwg % NXCD, xcd = wgid % NXCD, off = wgid / NXCD; wgid = (xcd < r ? xcd * (q + 1) : r * (q + 1) + (xcd - r) * q) + off; }
        const int nig = WGM * nN, gid = wgid / nig, fm = gid * WGM, gsz = (nM - fm) < WGM ? (nM - fm) : WGM;
        u.pm = fm + ((wgid % nig) % gsz); u.pn = (wgid % nig) / gsz; return true;
    }
    __device__ __forceinline__ void a_ready(const Unit&) const {}
    __device__ __forceinline__ void done(const Unit&) const {}
};

template <class Epi, class Sched, bool ALIGN_EPI = false, bool SP2 = false>
__device__ __forceinline__ void gemm_phase(PG8_LAS unsigned char* lds, const Gemm g, const Sched& S, const Epi& E) {
    const int tid = threadIdx.x, wid = __builtin_amdgcn_readfirstlane(tid >> 6), lane = tid & 63, wr = wid >> 2, wc = wid & 3, fr = lane & 15, fq = lane >> 4;
    const int K = g.K, nt = K / BK;
    unsigned voffA[2], voffB[2];
#pragma unroll
    for (int i = 0; i < 2; ++i) { int R, C; stage_rc(tid * 16 + i * 8192, R, C); const int Rb = Epi::PERM ? ((R & ~31) + perm32(R & 31)) : R;
        voffA[i] = (unsigned)(R * K + C) * 2u; voffB[i] = (unsigned)(Rb * K + C) * 2u; }
    const size_t kstep = (size_t)(BK * 2);
    const size_t hstep = (size_t)HALF * K * 2;
    const size_t tstep = 2 * hstep;
    const unsigned ldsw = (unsigned)wid * 1024u;
    const int aoff = lds_byte(wr * 64 + fr, fq * 8), boff = lds_byte(wc * 32 + fr, fq * 8);
#define PG8_SA(b, h) (((b) * 2 + (h)) * HTB)
#define PG8_SB(b, h) ((4 + (b) * 2 + (h)) * HTB)
#define PG8_STAGE(bufoff, gbase, voff) do { _Pragma("unroll") for (int _i = 0; _i < 2; ++_i) \
        __builtin_amdgcn_global_load_lds((const unsigned*)((const char*)(gbase) + (voff)[_i]), (PG8_LAS unsigned*)(lds + (bufoff) + ldsw + _i * 8192), 16, 0, 0); } while (0)
#define PG8_LDA(dst, b, h) do { _Pragma("unroll") for (int m = 0; m < 4; ++m) _Pragma("unroll") for (int k = 0; k < 2; ++k) dst[m][k] = *(const PG8_LAS bf16x8*)(lds + PG8_SA(b, h) + aoff + m * 2048 + k * 1024); } while (0)
#define PG8_LDB(dst, b, h) do { _Pragma("unroll") for (int n = 0; n < 2; ++n) _Pragma("unroll") for (int k = 0; k < 2; ++k) dst[n][k] = *(const PG8_LAS bf16x8*)(lds + PG8_SB(b, h) + boff + n * 2048 + k * 1024); } while (0)
#define PG8_MMA(ai, bj, At, Bt) do { __builtin_amdgcn_s_setprio(1); _Pragma("unroll") for (int m = 0; m < 4; ++m) _Pragma("unroll") for (int n = 0; n < 2; ++n) _Pragma("unroll") for (int k = 0; k < 2; ++k) \
        acc[ai][bj][m][n] = __builtin_amdgcn_mfma_f32_16x16x32_bf16(Bt[n][k], At[m][k], acc[ai][bj][m][n], 0, 0, 0); __builtin_amdgcn_s_setprio(0); } while (0)
#define PG8_WAIT_V(n) asm volatile("s_waitcnt vmcnt(" #n ")" ::: "memory")
#define PG8_WAIT_L(n) asm volatile("s_waitcnt lgkmcnt(" #n ")" ::: "memory")
#define PG8_BAR __builtin_amdgcn_s_barrier()
#define PG8_SCHED __builtin_amdgcn_sched_barrier(0)
    Unit cur, nxt; int ui = 0;
    if (!S.next(0, cur)) return;
    f32x4 acc[2][2][4][2];
#pragma unroll
    for (int a = 0; a < 2; ++a)
#pragma unroll
        for (int b = 0; b < 2; ++b)
#pragma unroll
            for (int m = 0; m < 4; ++m)
#pragma unroll
                for (int n = 0; n < 2; ++n) acc[a][b][m][n] = (f32x4){0.f, 0.f, 0.f, 0.f};
    bf16x8 At[4][2], B0[2][2], B1[2][2];
    const char* cA = (const char*)g.A + (size_t)cur.pm * tstep; const char* cB = (const char*)g.Bt + (size_t)cur.pn * tstep;
    S.a_ready(cur);
    if constexpr (SP2) {
        PG8_STAGE(PG8_SB(0, 0), cB, voffB); PG8_STAGE(PG8_SB(0, 1), cB + hstep, voffB); PG8_STAGE(PG8_SA(0, 0), cA, voffA); PG8_STAGE(PG8_SA(0, 1), cA + hstep, voffA);
        if (wr == 1) PG8_BAR;
        PG8_WAIT_V(2); PG8_BAR;
        PG8_STAGE(PG8_SB(1, 0), cB + kstep, voffB); PG8_STAGE(PG8_SA(1, 0), cA + kstep, voffA); PG8_STAGE(PG8_SB(1, 1), cB + hstep + kstep, voffB);
        PG8_WAIT_V(6); PG8_BAR;
    } else {
        PG8_STAGE(PG8_SB(0, 0), cB, voffB); PG8_STAGE(PG8_SA(0, 0), cA, voffA); PG8_STAGE(PG8_SB(0, 1), cB + hstep, voffB); PG8_STAGE(PG8_SA(0, 1), cA + hstep, voffA);
        if (wr == 1) PG8_BAR;
        PG8_WAIT_V(4); PG8_BAR;
        PG8_STAGE(PG8_SB(1, 0), cB + kstep, voffB); PG8_STAGE(PG8_SA(1, 0), cA + kstep, voffA); PG8_STAGE(PG8_SB(1, 1), cB + hstep + kstep, voffB);
        PG8_WAIT_V(6); PG8_BAR;
    }
    for (;;) {
        const bool has_next = S.next(ui + 1, nxt);
        const char* nA = has_next ? (const char*)g.A + (size_t)nxt.pm * tstep : cA; const char* nB = has_next ? (const char*)g.Bt + (size_t)nxt.pn * tstep : cB;
        for (int t = 0; t < nt; t += 2) {
            const bool last = (t == nt - 2);
            const char* a1 = cA + (size_t)(t + 1) * kstep;
            const char* a2 = last ? nA : cA + (size_t)(t + 2) * kstep; const char* b2 = last ? nB : cB + (size_t)(t + 2) * kstep;
            const char* a3 = a2 + kstep; const char* b3 = b2 + kstep;
            if (last && has_next) S.a_ready(nxt);
            if constexpr (SP2) {
            PG8_LDB(B0, 0, 0); PG8_LDB(B1, 0, 1); PG8_SCHED; PG8_LDA(At, 0, 0); PG8_STAGE(PG8_SA(1, 1), a1 + hstep, voffA);
            PG8_WAIT_V(8); PG8_WAIT_L(0); PG8_BAR; PG8_MMA(0, 0, At, B0); PG8_MMA(0, 1, At, B1); PG8_BAR; PG8_SCHED;
            PG8_LDA(At, 0, 1); PG8_STAGE(PG8_SB(0, 0), b2, voffB); PG8_STAGE(PG8_SB(0, 1), b2 + hstep, voffB); PG8_STAGE(PG8_SA(0, 0), a2, voffA);
            PG8_WAIT_V(8); PG8_WAIT_L(0); PG8_BAR; PG8_MMA(1, 0, At, B0); PG8_MMA(1, 1, At, B1); PG8_BAR; PG8_SCHED;
            PG8_LDB(B0, 1, 0); PG8_LDB(B1, 1, 1); PG8_SCHED; PG8_LDA(At, 1, 0); PG8_STAGE(PG8_SA(0, 1), a2 + hstep, voffA);
            PG8_WAIT_V(8); PG8_WAIT_L(0); PG8_BAR; PG8_MMA(0, 0, At, B0); PG8_MMA(0, 1, At, B1); PG8_BAR; PG8_SCHED;
            PG8_LDA(At, 1, 1); PG8_STAGE(PG8_SB(1, 0), b3, voffB); PG8_STAGE(PG8_SB(1, 1), b3 + hstep, voffB); PG8_STAGE(PG8_SA(1, 0), a3, voffA);
            PG8_WAIT_V(8); PG8_WAIT_L(0); PG8_BAR; PG8_MMA(1, 0, At, B0); PG8_MMA(1, 1, At, B1); PG8_BAR; PG8_SCHED;
            } else {
            PG8_LDB(B0, 0, 0); PG8_SCHED; PG8_LDA(At, 0, 0); PG8_STAGE(PG8_SA(1, 1), a1 + hstep, voffA);
            PG8_WAIT_L(8); PG8_BAR; PG8_WAIT_L(0); PG8_MMA(0, 0, At, B0); PG8_BAR; PG8_SCHED;
            PG8_LDB(B1, 0, 1); PG8_STAGE(PG8_SB(0, 0), b2, voffB);
            PG8_BAR; PG8_WAIT_L(0); PG8_MMA(0, 1, At, B1); PG8_BAR;
            PG8_LDA(At, 0, 1); PG8_STAGE(PG8_SA(0, 0), a2, voffA);
            PG8_BAR; PG8_WAIT_L(0); PG8_MMA(1, 0, At, B0); PG8_BAR; PG8_SCHED;
            PG8_STAGE(PG8_SB(0, 1), b2 + hstep, voffB);
            PG8_WAIT_V(6); PG8_BAR; PG8_MMA(1, 1, At, B1); PG8_BAR;
            PG8_LDB(B0, 1, 0); PG8_SCHED; PG8_LDA(At, 1, 0); PG8_STAGE(PG8_SA(0, 1), a2 + hstep, voffA);
            PG8_WAIT_L(8); PG8_BAR; PG8_WAIT_L(0); PG8_MMA(0, 0, At, B0); PG8_BAR; PG8_SCHED;
            PG8_LDB(B1, 1, 1); PG8_STAGE(PG8_SB(1, 0), b3, voffB);
            PG8_BAR; PG8_WAIT_L(0); PG8_MMA(0, 1, At, B1); PG8_BAR;
            PG8_LDA(At, 1, 1); PG8_STAGE(PG8_SA(1, 0), a3, voffA);
            PG8_BAR; PG8_WAIT_L(0); PG8_MMA(1, 0, At, B0); PG8_BAR; PG8_SCHED;
            PG8_STAGE(PG8_SB(1, 1), b3 + hstep, voffB);
            PG8_WAIT_V(6); PG8_BAR; PG8_MMA(1, 1, At, B1); PG8_BAR;
            }
        }
        if constexpr (ALIGN_EPI) { if (wr == 0) PG8_BAR; }
        E(acc, cur, wr, wc, fr, fq); S.done(cur);
        if (!has_next) break;
#pragma unroll
        for (int a = 0; a < 2; ++a)
#pragma unroll
            for (int b = 0; b < 2; ++b)
#pragma unroll
                for (int m = 0; m < 4; ++m)
#pragma unroll
                    for (int n = 0; n < 2; ++n) acc[a][b][m][n] = (f32x4){0.f, 0.f, 0.f, 0.f};
        cur = nxt; cA = nA; cB = nB; ++ui;
        if constexpr (ALIGN_EPI) { if (wr == 1) PG8_BAR; }
    }
    PG8_WAIT_V(0);
    if constexpr (!ALIGN_EPI) { if (wr == 0) PG8_BAR; }
    PG8_BAR;
#undef PG8_SA
#undef PG8_SB
#undef PG8_STAGE
#undef PG8_LDA
#undef PG8_LDB
#undef PG8_MMA
#undef PG8_WAIT_V
#undef PG8_WAIT_L
#undef PG8_BAR
#undef PG8_SCHED
}
}

struct EpiInProj {
    static constexpr bool PERM = true;
    unsigned char* ws; const float* bias; float* out;
    __device__ __forceinline__ void operator()(const f32x4 (&acc)[2][2][4][2], const pg8::Unit& u, int wr, int wc, int fr, int fq) const {
        const int colt = u.pn * 256, t = colt >> 9, cl = colt & 511;
        bf16* base = (bf16*)(ws + WS_QA + (size_t)t * (33 * MiB) + (t >= 2 ? 4 * MiB : 0) + (t >= 3 ? 4 * MiB : 0));
        const float sc = (t == 0) ? QSCALE : ((t == 4) ? KBSCALE : 1.f);
        const int row0 = u.pm * 256 + wr * 64 + fr, col0 = cl + wc * 32 + 8 * fq, bcol0 = colt + wc * 32 + 8 * fq;
        const bool kv = (t == 1 || t == 2);
        const bool ptail = kv && ((u.pm & 63) >= 62) && (u.pm < 128);
        const bool samp = (u.pm >= 128);
        const bool wf32 = kv && (samp || ptail);
        const size_t foff = (samp ? O_KS : O_KP) + ((t == 2) ? (samp ? (O_VS - O_KS) : (O_VP - O_KP)) : (size_t)0);
        float* of32 = out + foff;
        f32x4 bv[2][2];
#pragma unroll
        for (int bj = 0; bj < 2; ++bj)
#pragma unroll
            for (int n = 0; n < 2; ++n) bv[bj][n] = *(const f32x4*)(bias + bcol0 + bj * 128 + 4 * n);
#pragma unroll
        for (int ai = 0; ai < 2; ++ai)
#pragma unroll
            for (int m = 0; m < 4; ++m) {
                const int row = row0 + ai * 128 + m * 16;
                int orow = row;
                if (kv && samp) { const int s = row - MP; orow = MP + (s >> 6) * 576 + 512 + (s & 63); }
                long frow = 0;
                if (wf32) frow = samp ? (long)(row - MP) : (long)((row >> 14) * 512 + ((row & (SEQ - 1)) - (SEQ - 512)));
#pragma unroll
                for (int bj = 0; bj < 2; ++bj) {
                    f32x4 v0 = acc[ai][bj][m][0] + bv[bj][0], v1 = acc[ai][bj][m][1] + bv[bj][1];
                    if (wf32) { float* fp = of32 + frow * 512 + col0 + bj * 128; *(f32x4*)fp = v0; *(f32x4*)(fp + 4) = v1; }
                    if (t == 6) {
#pragma unroll
                        for (int e = 0; e < 4; ++e) { v0[e] = __builtin_amdgcn_rcpf(1.f + __expf(-v0[e])); v1[e] = __builtin_amdgcn_rcpf(1.f + __expf(-v1[e])); }
                    }
                    v0 = v0 * sc; v1 = v1 * sc;
                    v4u w; w.x = cvt_pk_bf16(v0[0], v0[1]); w.y = cvt_pk_bf16(v0[2], v0[3]); w.z = cvt_pk_bf16(v1[0], v1[1]); w.w = cvt_pk_bf16(v1[2], v1[3]);
                    *(v4u*)(base + (size_t)orow * AW + col0 + bj * 128) = w;
                }
            }
    }
};
struct EpiZ1 {
    static constexpr bool PERM = true;
    const float* xp; const float* xs; bf16* z1; float* stat; bool do_stat;
    __device__ __forceinline__ void operator()(const f32x4 (&acc)[2][2][4][2], const pg8::Unit& u, int wr, int wc, int fr, int fq) const {
        const int row0 = u.pm * 256 + wr * 64 + fr, col0 = u.pn * 256 + wc * 32 + 8 * fq;
#pragma unroll
        for (int ai = 0; ai < 2; ++ai)
#pragma unroll
            for (int m = 0; m < 4; ++m) {
                const int row = row0 + ai * 128 + m * 16;
                const float* xr = (row < MP) ? xp + (size_t)row * DM : xs + (size_t)(row - MP) * DM;
                float s = 0.f, q = 0.f;
#pragma unroll
                for (int bj = 0; bj < 2; ++bj) {
                    const f32x4 x0 = *(const f32x4*)(xr + col0 + bj * 128), x1 = *(const f32x4*)(xr + col0 + bj * 128 + 4);
                    const f32x4 v0 = x0 * ALPHA + acc[ai][bj][m][0], v1 = x1 * ALPHA + acc[ai][bj][m][1];
                    s += (v0[0] + v0[1]) + (v0[2] + v0[3]) + (v1[0] + v1[1]) + (v1[2] + v1[3]);
                    q += (v0[0] * v0[0] + v0[1] * v0[1]) + (v0[2] * v0[2] + v0[3] * v0[3]) + (v1[0] * v1[0] + v1[1] * v1[1]) + (v1[2] * v1[2] + v1[3] * v1[3]);
                    v4u w; w.x = cvt_pk_bf16(v0[0], v0[1]); w.y = cvt_pk_bf16(v0[2], v0[3]); w.z = cvt_pk_bf16(v1[0], v1[1]); w.w = cvt_pk_bf16(v1[2], v1[3]);
                    *(v4u*)(z1 + (size_t)row * DM + col0 + bj * 128) = w;
                }
                s += __shfl_xor(s, 16); s += __shfl_xor(s, 32); q += __shfl_xor(q, 16); q += __shfl_xor(q, 32);
                if (fq == 0 && do_stat) { atomicAdd(stat + 2 * row, s); atomicAdd(stat + 2 * row + 1, q); }
            }
    }
};
struct EpiFfn1 {
    static constexpr bool PERM = true;
    const float* stat; const float* c1; const float* c2; bf16* hid;
    __device__ __forceinline__ void operator()(const f32x4 (&acc)[2][2][4][2], const pg8::Unit& u, int wr, int wc, int fr, int fq) const {
        const int row0 = u.pm * 256 + wr * 64 + fr, col0 = u.pn * 256 + wc * 32 + 8 * fq;
        f32x4 k1[2][2], k2[2][2];
#pragma unroll
        for (int bj = 0; bj < 2; ++bj)
#pragma unroll
            for (int n = 0; n < 2; ++n) { k1[bj][n] = *(const f32x4*)(c1 + col0 + bj * 128 + 4 * n); k2[bj][n] = *(const f32x4*)(c2 + col0 + bj * 128 + 4 * n); }
#pragma unroll
        for (int ai = 0; ai < 2; ++ai)
#pragma unroll
            for (int m = 0; m < 4; ++m) {
                const int row = row0 + ai * 128 + m * 16;
                const f32x2 st = *(const f32x2*)(stat + 2 * row);
                const float mean = st.x * (1.f / DM), var = fmaxf(st.y * (1.f / DM) - mean * mean, 0.f), rstd = 1.0f / sqrtf(var + LN_EPS);
#pragma unroll
                for (int bj = 0; bj < 2; ++bj) {
                    f32x4 v0 = (acc[ai][bj][m][0] - k1[bj][0] * mean) * rstd + k2[bj][0], v1 = (acc[ai][bj][m][1] - k1[bj][1] * mean) * rstd + k2[bj][1];
#pragma unroll
                    for (int e = 0; e < 4; ++e) { const float a = fmaxf(v0[e], 0.f), b = fmaxf(v1[e], 0.f); v0[e] = a * a; v1[e] = b * b; }
                    v4u w; w.x = cvt_pk_bf16(v0[0], v0[1]); w.y = cvt_pk_bf16(v0[2], v0[3]); w.z = cvt_pk_bf16(v1[0], v1[1]); w.w = cvt_pk_bf16(v1[2], v1[3]);
                    *(v4u*)(hid + (size_t)row * FF + col0 + bj * 128) = w;
                }
            }
    }
};
struct EpiFfn2 {
    static constexpr bool PERM = true;
    const float* stat; const bf16* z1; const float* g1; const float* b1; const float* bias; float* out;
    __device__ __forceinline__ void operator()(const f32x4 (&acc)[2][2][4][2], const pg8::Unit& u, int wr, int wc, int fr, int fq) const {
        const int row0 = u.pm * 256 + wr * 64 + fr, col0 = u.pn * 256 + wc * 32 + 8 * fq;
        f32x4 gg[2][2], bb[2][2], bo[2][2];
#pragma unroll
        for (int bj = 0; bj < 2; ++bj)
#pragma unroll
            for (int n = 0; n < 2; ++n) { gg[bj][n] = *(const f32x4*)(g1 + col0 + bj * 128 + 4 * n); bb[bj][n] = *(const f32x4*)(b1 + col0 + bj * 128 + 4 * n); bo[bj][n] = *(const f32x4*)(bias + col0 + bj * 128 + 4 * n); }
#pragma unroll
        for (int ai = 0; ai < 2; ++ai)
#pragma unroll
            for (int m = 0; m < 4; ++m) {
                const int row = row0 + ai * 128 + m * 16;
                const f32x2 st = *(const f32x2*)(stat + 2 * row);
                const float mean = st.x * (1.f / DM), var = fmaxf(st.y * (1.f / DM) - mean * mean, 0.f), rstd = 1.0f / sqrtf(var + LN_EPS);
#pragma unroll
                for (int bj = 0; bj < 2; ++bj) {
                    const v4u zz = *(const v4u*)(z1 + (size_t)row * DM + col0 + bj * 128);
                    const f32x4 z0 = (f32x4){bflo(zz.x), bfhi(zz.x), bflo(zz.y), bfhi(zz.y)}, z1v = (f32x4){bflo(zz.z), bfhi(zz.z), bflo(zz.w), bfhi(zz.w)};
                    const f32x4 h0 = (z0 - mean) * rstd * gg[bj][0] + bb[bj][0], h1 = (z1v - mean) * rstd * gg[bj][1] + bb[bj][1];
                    const f32x4 o0 = h0 * ALPHA + acc[ai][bj][m][0] + bo[bj][0], o1 = h1 * ALPHA + acc[ai][bj][m][1] + bo[bj][1];
                    float* op = out + (size_t)row * DM + col0 + bj * 128;
                    *(f32x4*)op = o0; *(f32x4*)(op + 4) = o1;
                }
            }
    }
};

struct Args { const float* in[20]; float* out; unsigned char* ws; int ph_lo, ph_hi, coop, pad; };
struct Frame {
    LAS unsigned char* lds;
    int tid, lane, wave, vcu, G;
    float* out; unsigned char* ws;
};

template <class Epi>
__device__ __forceinline__ void small_gemm_phase(Frame& F, const bf16* A, const bf16* Bt, int N, int K, const Epi& E) {
    const int tid = F.tid, lane = F.lane, wid = F.wave, r32 = lane & 31, hi = lane >> 5;
    const int ntn = N / 64, total = 8 * ntn, ks = K / 8;
    LAS float* red = (LAS float*)F.lds;
    for (int tile = F.vcu; tile < total; tile += F.G) {
        const int tm = tile & 7, tn = tile >> 3;
        const bf16* ap = A + (size_t)(64 * tm + r32) * K + wid * ks + 8 * hi;
        const bf16* bp = Bt + (size_t)(64 * tn + r32) * K + wid * ks + 8 * hi;
        f32x16 acc[2][2];
#pragma unroll
        for (int i = 0; i < 2; ++i)
#pragma unroll
            for (int j = 0; j < 2; ++j)
#pragma unroll
                for (int r = 0; r < 16; ++r) acc[i][j][r] = 0.f;
#pragma unroll 4
        for (int k0 = 0; k0 < ks; k0 += 16) {
            const bf16x8 a0 = *(const bf16x8*)(ap + k0), a1 = *(const bf16x8*)(ap + (size_t)32 * K + k0);
            const bf16x8 b0 = *(const bf16x8*)(bp + k0), b1 = *(const bf16x8*)(bp + (size_t)32 * K + k0);
            acc[0][0] = __builtin_amdgcn_mfma_f32_32x32x16_bf16(a0, b0, acc[0][0], 0, 0, 0);
            acc[0][1] = __builtin_amdgcn_mfma_f32_32x32x16_bf16(a0, b1, acc[0][1], 0, 0, 0);
            acc[1][0] = __builtin_amdgcn_mfma_f32_32x32x16_bf16(a1, b0, acc[1][0], 0, 0, 0);
            acc[1][1] = __builtin_amdgcn_mfma_f32_32x32x16_bf16(a1, b1, acc[1][1], 0, 0, 0);
        }
#pragma unroll
        for (int i = 0; i < 2; ++i)
#pragma unroll
            for (int j = 0; j < 2; ++j)
#pragma unroll
                for (int r = 0; r < 16; ++r) red[wid * 4096 + (32 * i + crow(r, hi)) * 64 + 32 * j + r32] = acc[i][j][r];
        __syncthreads();
        {
            const int row = tid >> 3, cg = tid & 7;
            f32x4 v0 = (f32x4){0.f, 0.f, 0.f, 0.f}, v1 = v0;
#pragma unroll
            for (int w = 0; w < 8; ++w) { v0 += *(const LAS f32x4*)(red + w * 4096 + row * 64 + 8 * cg); v1 += *(const LAS f32x4*)(red + w * 4096 + row * 64 + 8 * cg + 4); }
            E(MP + 64 * tm + row, 64 * tn + 8 * cg, v0, v1, cg);
        }
        __syncthreads();
    }
}
struct SEpiInProj {
    unsigned char* ws; const float* bias; float* out;
    __device__ __forceinline__ void operator()(int row, int col, f32x4 v0, f32x4 v1, int) const {
        const int t = col >> 9, cl = col & 511;
        bf16* base = (bf16*)(ws + WS_QA + (size_t)t * (33 * MiB) + (t >= 2 ? 4 * MiB : 0) + (t >= 3 ? 4 * MiB : 0));
        const float sc = (t == 0) ? QSCALE : ((t == 4) ? KBSCALE : 1.f);
        v0 += *(const f32x4*)(bias + col); v1 += *(const f32x4*)(bias + col + 4);
        int orow = row;
        if (t == 1 || t == 2) { const int s = row - MP; orow = MP + (s >> 6) * 576 + 512 + (s & 63);
            float* fp = out + (t == 1 ? O_KS : O_VS) + (size_t)s * 512 + cl; *(f32x4*)fp = v0; *(f32x4*)(fp + 4) = v1; }
        if (t == 6) {
#pragma unroll
            for (int e = 0; e < 4; ++e) { v0[e] = __builtin_amdgcn_rcpf(1.f + __expf(-v0[e])); v1[e] = __builtin_amdgcn_rcpf(1.f + __expf(-v1[e])); }
        }
        v0 = v0 * sc; v1 = v1 * sc;
        v4u w; w.x = cvt_pk_bf16(v0[0], v0[1]); w.y = cvt_pk_bf16(v0[2], v0[3]); w.z = cvt_pk_bf16(v1[0], v1[1]); w.w = cvt_pk_bf16(v1[2], v1[3]);
        *(v4u*)(base + (size_t)orow * AW + cl) = w;
    }
};
struct SEpiZ1 {
    const float* xs; bf16* z1; float* stat;
    __device__ __forceinline__ void operator()(int row, int col, f32x4 a0, f32x4 a1, int cg) const {
        const float* xr = xs + (size_t)(row - MP) * DM + col;
        const f32x4 v0 = *(const f32x4*)xr * ALPHA + a0, v1 = *(const f32x4*)(xr + 4) * ALPHA + a1;
        float s = (v0[0] + v0[1]) + (v0[2] + v0[3]) + (v1[0] + v1[1]) + (v1[2] + v1[3]);
        float q = (v0[0] * v0[0] + v0[1] * v0[1]) + (v0[2] * v0[2] + v0[3] * v0[3]) + (v1[0] * v1[0] + v1[1] * v1[1]) + (v1[2] * v1[2] + v1[3] * v1[3]);
        v4u w; w.x = cvt_pk_bf16(v0[0], v0[1]); w.y = cvt_pk_bf16(v0[2], v0[3]); w.z = cvt_pk_bf16(v1[0], v1[1]); w.w = cvt_pk_bf16(v1[2], v1[3]);
        *(v4u*)(z1 + (size_t)row * DM + col) = w;
        s += __shfl_xor(s, 1); s += __shfl_xor(s, 2); s += __shfl_xor(s, 4); q += __shfl_xor(q, 1); q += __shfl_xor(q, 2); q += __shfl_xor(q, 4);
        if (cg == 0) { atomicAdd(stat + 2 * row, s); atomicAdd(stat + 2 * row + 1, q); }
    }
};
struct SEpiFfn1 {
    const float* stat; const float* c1; const float* c2; bf16* hid;
    __device__ __forceinline__ void operator()(int row, int col, f32x4 a0, f32x4 a1, int) const {
        const f32x2 st = *(const f32x2*)(stat + 2 * row);
        const float mean = st.x * (1.f / DM), var = fmaxf(st.y * (1.f / DM) - mean * mean, 0.f), rstd = 1.0f / sqrtf(var + LN_EPS);
        f32x4 v0 = (a0 - *(const f32x4*)(c1 + col) * mean) * rstd + *(const f32x4*)(c2 + col), v1 = (a1 - *(const f32x4*)(c1 + col + 4) * mean) * rstd + *(const f32x4*)(c2 + col + 4);
#pragma unroll
        for (int e = 0; e < 4; ++e) { const float a = fmaxf(v0[e], 0.f), b = fmaxf(v1[e], 0.f); v0[e] = a * a; v1[e] = b * b; }
        v4u w; w.x = cvt_pk_bf16(v0[0], v0[1]); w.y = cvt_pk_bf16(v0[2], v0[3]); w.z = cvt_pk_bf16(v1[0], v1[1]); w.w = cvt_pk_bf16(v1[2], v1[3]);
        *(v4u*)(hid + (size_t)row * FF + col) = w;
    }
};
struct SEpiFfn2 {
    const float* stat; const bf16* z1; const float* g1; const float* b1; const float* bias; float* out;
    __device__ __forceinline__ void operator()(int row, int col, f32x4 a0, f32x4 a1, int) const {
        const f32x2 st = *(const f32x2*)(stat + 2 * row);
        const float mean = st.x * (1.f / DM), var = fmaxf(st.y * (1.f / DM) - mean * mean, 0.f), rstd = 1.0f / sqrtf(var + LN_EPS);
        const v4u zz = *(const v4u*)(z1 + (size_t)row * DM + col);
        const f32x4 z0 = (f32x4){bflo(zz.x), bfhi(zz.x), bflo(zz.y), bfhi(zz.y)}, z1v = (f32x4){bflo(zz.z), bfhi(zz.z), bflo(zz.w), bfhi(zz.w)};
        const f32x4 h0 = (z0 - mean) * rstd * *(const f32x4*)(g1 + col) + *(const f32x4*)(b1 + col), h1 = (z1v - mean) * rstd * *(const f32x4*)(g1 + col + 4) + *(const f32x4*)(b1 + col + 4);
        float* op = out + (size_t)row * DM + col;
        *(f32x4*)op = h0 * ALPHA + a0 + *(const f32x4*)(bias + col); *(f32x4*)(op + 4) = h1 * ALPHA + a1 + *(const f32x4*)(bias + col + 4);
    }
};


template <bool FOLD>
__device__ __forceinline__ void p0_transpose_item(const float* W, int K, int N, int ldw, bf16* WT, LAS float* scr, int item, int lane,
                                                  const float* g, const float* b, float* c1p, float* c2p) {
    const int nblk = N / 32, kb = item / nblk, nb = item % nblk, k0 = 64 * kb, n0 = 32 * nb;
#pragma unroll 8
    for (int i = 0; i < 32; ++i) { const int kk = 2 * i + (lane >> 5); scr[kk * 33 + (lane & 31)] = W[(size_t)(k0 + kk) * ldw + n0 + (lane & 31)]; }
    LDS_WAIT(); asm volatile("" ::: "memory");
    if constexpr (FOLD) {
        const int n = lane & 31, hf = lane >> 5; float s1 = 0.f, s2 = 0.f;
#pragma unroll 8
        for (int i = 0; i < 32; ++i) { const int kk = hf * 32 + i; const float w = scr[kk * 33 + n]; const float gw = w * g[k0 + kk];
            const float gr = __builtin_bit_cast(float, f2bf(gw) << 16); s1 += gr; s2 += w * b[k0 + kk]; scr[kk * 33 + n] = gw; }
        s1 += __shfl_xor(s1, 32); s2 += __shfl_xor(s2, 32);
        if (lane < 32) { c1p[(size_t)kb * N + n0 + n] = s1; c2p[(size_t)kb * N + n0 + n] = s2; }
        LDS_WAIT(); asm volatile("" ::: "memory");
    }
    const int c = lane & 7;
#pragma unroll
    for (int j = 0; j < 4; ++j) { const int n = (lane >> 3) + 8 * j; const LAS float* s = scr + (8 * c) * 33 + n;
        v4u o; o.x = pk2(s[0 * 33], s[1 * 33]); o.y = pk2(s[2 * 33], s[3 * 33]); o.z = pk2(s[4 * 33], s[5 * 33]); o.w = pk2(s[6 * 33], s[7 * 33]);
        *(GAS v4u*)(WT + (size_t)(n0 + n) * K + k0 + 8 * c) = o; }
    LDS_WAIT(); asm volatile("" ::: "memory");
}

__device__ __forceinline__ void p0_prologue(Frame& F, const Args& A) {
    const float* xp = A.in[0]; const float* xs = A.in[1]; const float* ck = A.in[2]; const float* cv = A.in[3];
    const float* w_in = A.in[7]; const float* b_in = A.in[8]; const float* w_out = A.in[11]; const float* ln1g = A.in[12]; const float* ln1b = A.in[13];
    const float* w1 = A.in[14]; const float* w2 = A.in[16];
    bf16* WIN = (bf16*)(F.ws + WS_WIN); bf16* WOUT = (bf16*)(F.ws + WS_WOUT); bf16* W1T = (bf16*)(F.ws + WS_W1); bf16* W2T = (bf16*)(F.ws + WS_W2);
    bf16* XB = (bf16*)(F.ws + WS_XB); bf16* KA = (bf16*)(F.ws + WS_KA); bf16* VA = (bf16*)(F.ws + WS_VA);
    float* IG = (float*)(F.ws + WS_IG); float* LFp = (float*)(F.ws + WS_LF); float* STAT = (float*)(F.ws + WS_STAT1);
    float* C1P = (float*)(F.ws + WS_C1P); float* C2P = (float*)(F.ws + WS_C2P);
    LAS float* scr = (LAS float*)(F.lds + F.wave * 8704);
    LAS float* wg = (LAS float*)(F.lds + 98304);
    const int gw = F.vcu * 8 + F.wave, NGW = F.G * 8;
    for (int k = F.tid; k < DM; k += 512) { const f32x4 a = *(const f32x4*)(w_in + (size_t)k * INW + NIN), b = *(const f32x4*)(w_in + (size_t)k * INW + NIN + 4);
        wg[0 * DM + k] = a[0]; wg[1 * DM + k] = a[1]; wg[2 * DM + k] = a[2]; wg[3 * DM + k] = a[3]; wg[4 * DM + k] = b[0]; wg[5 * DM + k] = b[1]; wg[6 * DM + k] = b[2]; wg[7 * DM + k] = b[3]; }
    for (int i = (int)blockIdx.x * 512 + F.tid; i < MT * 2; i += F.G * 512) STAT[i] = 0.f;
    __syncthreads();
    constexpr int I_IN = (DM / 64) * (NIN / 32), I_OUT = (DM / 64) * (DM / 32), I_1 = (DM / 64) * (FF / 32), I_2 = (FF / 64) * (DM / 32);
    constexpr int NITEMS = I_IN + I_OUT + I_1 + I_2;
    for (int it = gw; it < NITEMS; it += NGW) {
        int r = it;
        if (r < I_IN) { p0_transpose_item<false>(w_in, DM, NIN, INW, WIN, scr, r, F.lane, nullptr, nullptr, nullptr, nullptr); continue; } r -= I_IN;
        if (r < I_OUT) { p0_transpose_item<false>(w_out, DM, DM, DM, WOUT, scr, r, F.lane, nullptr, nullptr, nullptr, nullptr); continue; } r -= I_OUT;
        if (r < I_1) { p0_transpose_item<true>(w1, DM, FF, FF, W1T, scr, r, F.lane, ln1g, ln1b, C1P, C2P); continue; } r -= I_1;
        p0_transpose_item<false>(w2, FF, DM, DM, W2T, scr, r, F.lane, nullptr, nullptr, nullptr, nullptr);
    }
    for (int m = gw; m < MT; m += NGW) {
        const float* xrow = (m < MP) ? xp + (size_t)m * DM : xs + (size_t)(m - MP) * DM;
        const GAS f32x4* xr = (const GAS f32x4*)xrow + F.lane;
        f32x4 v[4]; float a[8];
#pragma unroll
        for (int g = 0; g < 8; ++g) a[g] = 0.f;
#pragma unroll
        for (int j = 0; j < 4; ++j) v[j] = xr[64 * j];
#pragma unroll
        for (int j = 0; j < 4; ++j)
#pragma unroll
            for (int g = 0; g < 8; ++g) { const f32x4 w = *(const LAS f32x4*)(wg + g * DM + 256 * j + 4 * F.lane); a[g] += (v[j][0] * w[0] + v[j][1] * w[1]) + (v[j][2] * w[2] + v[j][3] * w[3]); }
        GAS unsigned long long* o8 = (GAS unsigned long long*)(XB + (size_t)m * DM) + F.lane;
#pragma unroll
        for (int j = 0; j < 4; ++j) o8[64 * j] = (unsigned long long)pk2(v[j][0], v[j][1]) | ((unsigned long long)pk2(v[j][2], v[j][3]) << 32);
#pragma unroll
        for (int g = 0; g < 8; ++g) a[g] = wave_sum(a[g]);
        if (F.lane < 8) {
            float val = a[0];
#pragma unroll
            for (int g = 1; g < 8; ++g) val = (F.lane == g) ? a[g] : val;
            val += b_in[NIN + F.lane];
            if (F.lane < 4) IG[(size_t)m * 4 + F.lane] = val;
            else { const float ls = fminf(val, 0.f) - log1pf(__expf(-fabsf(val))); LFp[(size_t)m * 4 + F.lane - 4] = ls; }
        }
    }
    for (int it = gw; it < 2 * DB * 512; it += NGW) {
        const int which = it >= DB * 512, r = which ? it - DB * 512 : it, db = r >> 9, rr = r & 511;
        const float* src = (which ? cv : ck) + (size_t)r * AW + 8 * F.lane;
        const f32x4 a = *(const f32x4*)src, b = *(const f32x4*)(src + 4);
        v4u o; o.x = pk2(a[0], a[1]); o.y = pk2(a[2], a[3]); o.z = pk2(b[0], b[1]); o.w = pk2(b[2], b[3]);
        *(v4u*)((which ? VA : KA) + (size_t)(MP + db * 576 + rr) * AW + 8 * F.lane) = o;
    }
}

constexpr int AT_K = 0, AT_V = 16384, AT_BIAS = 32768, AT_WS = 34816, AT_OST = 36864;
__device__ __forceinline__ void attn_unit(Frame& F, const bf16* Q, const bf16* K, const bf16* V, bf16* MIX, const float* relb,
                                          int h, long qrow_base, long kv_base, int i_lo, int i_hi, int nactive) {
    const int tid = F.tid, lane = F.lane, r32 = lane & 31, hi = lane >> 5, wid = F.wave;
    const int wq = wid >> 1, wh = wid & 1;
    const bool active = wid < nactive;
    LAS unsigned char* lds = F.lds;
    LAS float* bias = (LAS float*)(lds + AT_BIAS);
    LAS float* wsf = (LAS float*)(lds + AT_WS) + wid * 64;
    if (tid < 257) bias[tid] = relb[h * 257 + tid] * LOG2E;
    const long qrow = qrow_base + 64 * wq + 32 * wh;
    bf16x8 qr[4];
#pragma unroll
    for (int d0 = 0; d0 < 4; ++d0) qr[d0] = (bf16x8){0, 0, 0, 0, 0, 0, 0, 0};
    if (active) {
#pragma unroll
        for (int d0 = 0; d0 < 4; ++d0) qr[d0] = *(const bf16x8*)(Q + (qrow + r32) * AW + h * 64 + d0 * 16 + hi * 8);
    }
    float m_run = -1e30f, l_run = 0.f;
    f32x16 o[2];
#pragma unroll
    for (int r = 0; r < 16; ++r) { o[0][r] = 0.f; o[1][r] = 0.f; }
    const unsigned ldsw = (unsigned)wid * 1024u;
#define AT_STAGE(i_, buf_) do { const long trow = kv_base + 64 * (long)(i_); \
        const bf16* ksrc = K + (trow + lane) * AW + h * 64 + wid * 8; \
        const bf16* vsrc = V + (trow + 16 * (wid & 3) + (lane >> 2)) * AW + h * 64 + (wid >> 2) * 32 + (lane & 3) * 8; \
        __builtin_amdgcn_global_load_lds((const unsigned*)ksrc, (LAS unsigned*)(lds + AT_K + (buf_) * 8192 + ldsw), 16, 0, 0); \
        __builtin_amdgcn_global_load_lds((const unsigned*)vsrc, (LAS unsigned*)(lds + AT_V + (buf_) * 8192 + ldsw), 16, 0, 0); } while (0)
    AT_STAGE(i_lo, 0);
    int cur = 0;
    for (int i = i_lo; i <= i_hi; ++i) {
        VM_WAIT(); __syncthreads();
        if (i + 1 <= i_hi) AT_STAGE(i + 1, cur ^ 1);
        if (active && i >= wq && i <= wq + 8) {
            const int delta = wq + 8 - i;
            const LAS unsigned char* kb = lds + AT_K + cur * 8192 + hi * 1024 + r32 * 16;
            const float cinit = (delta >= 3) ? bias[256] : 0.f;
            f32x16 p0, p1;
#pragma unroll
            for (int r = 0; r < 16; ++r) { p0[r] = cinit; p1[r] = cinit; }
#pragma unroll
            for (int d0 = 0; d0 < 4; ++d0) {
                const bf16x8 b0 = *(const LAS bf16x8*)(kb + d0 * 2048), b1 = *(const LAS bf16x8*)(kb + d0 * 2048 + 512);
                p0 = __builtin_amdgcn_mfma_f32_32x32x16_bf16(b0, qr[d0], p0, 0, 0, 0);
                p1 = __builtin_amdgcn_mfma_f32_32x32x16_bf16(b1, qr[d0], p1, 0, 0, 0);
            }
            if (delta <= 2) {
                const int bs = 64 * delta + 32 * wh + r32 + 128;
#pragma unroll
                for (int r = 0; r < 16; ++r) { const int kj = crow(r, hi); int i0 = bs - kj, i1 = bs - kj - 32; i0 = i0 > 256 ? 256 : i0; i1 = i1 > 256 ? 256 : i1; i0 = i0 < 0 ? 0 : i0; i1 = i1 < 0 ? 0 : i1;
                    p0[r] += bias[i0]; p1[r] += bias[i1]; }
            }
            float rm = fmaxf(p0[0], p1[0]);
#pragma unroll
            for (int r = 1; r < 16; ++r) rm = fmaxf(rm, fmaxf(p0[r], p1[r]));
            rm = swap_max(rm);
            if (__any(rm > m_run)) {
                const float mn = fmaxf(m_run, rm), f = __builtin_amdgcn_exp2f(m_run - mn);
                l_run *= f; m_run = mn;
                if (hi == 0) wsf[r32] = f;
                LDS_WAIT();
#pragma unroll
                for (int r = 0; r < 16; ++r) { const float fr_ = wsf[crow(r, hi)]; o[0][r] *= fr_; o[1][r] *= fr_; }
                LDS_WAIT();
            }
            float sacc = 0.f;
#pragma unroll
            for (int r = 0; r < 16; ++r) { p0[r] = __builtin_amdgcn_exp2f(p0[r] - m_run); p1[r] = __builtin_amdgcn_exp2f(p1[r] - m_run); sacc += p0[r] + p1[r]; }
            l_run += sacc;
            v4u pw[4];
            pw[0] = (v4u){cvt_pk_bf16(p0[0], p0[1]), cvt_pk_bf16(p0[2], p0[3]), cvt_pk_bf16(p0[4], p0[5]), cvt_pk_bf16(p0[6], p0[7])};
            pw[1] = (v4u){cvt_pk_bf16(p0[8], p0[9]), cvt_pk_bf16(p0[10], p0[11]), cvt_pk_bf16(p0[12], p0[13]), cvt_pk_bf16(p0[14], p0[15])};
            pw[2] = (v4u){cvt_pk_bf16(p1[0], p1[1]), cvt_pk_bf16(p1[2], p1[3]), cvt_pk_bf16(p1[4], p1[5]), cvt_pk_bf16(p1[6], p1[7])};
            pw[3] = (v4u){cvt_pk_bf16(p1[8], p1[9]), cvt_pk_bf16(p1[10], p1[11]), cvt_pk_bf16(p1[12], p1[13]), cvt_pk_bf16(p1[14], p1[15])};
            const LAS unsigned char* vb = lds + AT_V + cur * 8192 + ((lane >> 4) & 1) * 32 + (lane & 3) * 8 + (4 * hi + ((lane & 15) >> 2)) * 64;
#pragma unroll
            for (int d0 = 0; d0 < 2; ++d0)
#pragma unroll
                for (int ks = 0; ks < 4; ++ks) {
                    const bf16x8 vf = trfrag(vb + d0 * 4096 + ks * 1024);
                    o[d0] = __builtin_amdgcn_mfma_f32_32x32x16_bf16(__builtin_bit_cast(bf16x8, pw[ks]), vf, o[d0], 0, 0, 0);
                }
        }
        cur ^= 1;
    }
    if (active) {
        const float lt = swap_add(l_run);
        if (hi == 0) wsf[32 + r32] = lt;
        LDS_WAIT();
        LAS bf16* stg = (LAS bf16*)(lds + AT_OST) + wid * 2048;
#pragma unroll
        for (int r = 0; r < 16; ++r) { const int orow = crow(r, hi); const float rl = __builtin_amdgcn_rcpf(wsf[32 + orow]);
            stg[orow * 64 + r32] = (bf16)f2bf(o[0][r] * rl); stg[orow * 64 + 32 + r32] = (bf16)f2bf(o[1][r] * rl); }
        LDS_WAIT();
#pragma unroll
        for (int i = 0; i < 4; ++i) { const int row = i * 8 + (lane >> 3), ch = lane & 7; const v4u v = *(const LAS v4u*)(stg + row * 64 + ch * 8);
            *(v4u*)(MIX + (qrow + row) * DM + h * 64 + ch * 8) = v; }
    }
    LDS_WAIT();
    __syncthreads();
#undef AT_STAGE
}

__device__ __forceinline__ int tr_off(int s, int c16) { return (c16 >> 2) * 4096 + (s >> 4) * 1024 + (s & 15) * 64 + (c16 & 3) * 16; }
__device__ __forceinline__ int tr_read_base(int lane) { const int hi = lane >> 5; return ((lane >> 4) & 1) * 32 + (lane & 3) * 8 + (4 * hi + ((lane & 15) >> 2)) * 64; }
__device__ __forceinline__ v4u scale8(v4u k, float w) {
    v4u o; o.x = pk2(bflo(k.x) * w, bfhi(k.x) * w); o.y = pk2(bflo(k.y) * w, bfhi(k.y) * w); o.z = pk2(bflo(k.z) * w, bfhi(k.z) * w); o.w = pk2(bflo(k.w) * w, bfhi(k.w) * w); return o;
}

__device__ __forceinline__ void mlstm_stage1_item(Frame& F, int item) {
    const int tid = F.tid, lane = F.lane, wid = F.wave, r32 = lane & 31, hi = lane >> 5;
    const int seq = item >> 5, j = item & 31, b = seq >> 2, h = seq & 3;
    const long row0 = (long)b * SEQ + (long)j * 512;
    const bf16* KB = (const bf16*)(F.ws + WS_KB); const bf16* VB = (const bf16*)(F.ws + WS_VB);
    const float* IG = (const float*)(F.ws + WS_IG); const float* LFp = (const float*)(F.ws + WS_LF);
    LAS unsigned char* lds = F.lds;
    LAS float* wts = (LAS float*)(lds + 32768); LAS float* red = (LAS float*)(lds + 34816);
    const float lfv = LFp[(row0 + tid) * 4 + h], igv = IG[(row0 + tid) * 4 + h];
    float bs = lfv;
#pragma unroll
    for (int off = 1; off < 64; off <<= 1) { const float t = __shfl_up(bs, off); if (lane >= off) bs += t; }
    if (lane == 63) red[wid] = bs;
    __syncthreads();
    float woff = 0.f, btot = 0.f;
#pragma unroll
    for (int w = 0; w < 8; ++w) { const float t = red[w]; if (w < wid) woff += t; btot += t; }
    bs += woff;
    const float e = btot - bs + igv;
    float mx = e;
#pragma unroll
    for (int o = 1; o < 64; o <<= 1) mx = fmaxf(mx, __shfl_xor(mx, o));
    if (lane == 0) red[16 + wid] = mx;
    __syncthreads();
    float mloc = red[16];
#pragma unroll
    for (int w = 1; w < 8; ++w) mloc = fmaxf(mloc, red[16 + w]);
    wts[tid] = __expf(e - mloc);
    __syncthreads();
    f32x16 acc[2];
#pragma unroll
    for (int r = 0; r < 16; ++r) { acc[0][r] = 0.f; acc[1][r] = 0.f; }
    float nsum = 0.f;
    const int kb = wid >> 1, vb0 = 2 * (wid & 1);
    const int trb = tr_read_base(lane);
    for (int c = 0; c < 8; ++c) {
        v4u kv[2], vv[2];
#pragma unroll
        for (int i = 0; i < 2; ++i) { const int p = tid + 512 * i, row = p >> 4, c16 = p & 15;
            kv[i] = *(const v4u*)(KB + (row0 + c * 64 + row) * AW + h * 128 + c16 * 8); vv[i] = *(const v4u*)(VB + (row0 + c * 64 + row) * AW + h * 128 + c16 * 8); }
#pragma unroll
        for (int i = 0; i < 2; ++i) { const int p = tid + 512 * i, row = p >> 4, c16 = p & 15;
            *(LAS v4u*)(lds + tr_off(row, c16)) = scale8(kv[i], wts[c * 64 + row]); *(LAS v4u*)(lds + 16384 + tr_off(row, c16)) = vv[i]; }
        __syncthreads();
#pragma unroll
        for (int ks = 0; ks < 4; ++ks) {
            const bf16x8 af = trfrag(lds + kb * 4096 + ks * 1024 + trb);
#pragma unroll
            for (int vi = 0; vi < 2; ++vi) { const bf16x8 bfr = trfrag(lds + 16384 + (vb0 + vi) * 4096 + ks * 1024 + trb);
                acc[vi] = __builtin_amdgcn_mfma_f32_32x32x16_bf16(af, bfr, acc[vi], 0, 0, 0); }
        }
        if (tid < 128) {
            const int k = tid; float s = 0.f;
#pragma unroll 8
            for (int sidx = 0; sidx < 64; ++sidx) { const unsigned short w = *(const LAS unsigned short*)(lds + (k >> 5) * 4096 + (sidx >> 4) * 1024 + (sidx & 15) * 64 + (k & 31) * 2); s += __builtin_bit_cast(float, (unsigned)w << 16); }
            nsum += s;
        }
        __syncthreads();
    }
    float* U = (float*)(F.ws + WS_SCU) + (size_t)item * 16384;
#pragma unroll
    for (int vi = 0; vi < 2; ++vi) { const int v = 32 * (vb0 + vi) + r32;
#pragma unroll
        for (int g4 = 0; g4 < 4; ++g4) *(f32x4*)(U + v * 128 + 32 * kb + 8 * g4 + 4 * hi) = (f32x4){acc[vi][4 * g4], acc[vi][4 * g4 + 1], acc[vi][4 * g4 + 2], acc[vi][4 * g4 + 3]}; }
    if (tid < 128) ((float*)(F.ws + WS_SCNU))[item * 128 + tid] = nsum;
    if (tid == 0) { ((float*)(F.ws + WS_SCML))[item] = mloc; ((float*)(F.ws + WS_SCBS))[item] = btot; }
    __syncthreads();
}

__device__ __forceinline__ void p3_scan(Frame& F, const float* bff1) {
    const int gid = F.vcu * 512 + F.tid, NT = F.G * 512;
    const float* U = (const float*)(F.ws + WS_SCU); const float* NU = (const float*)(F.ws + WS_SCNU);
    const float* ML = (const float*)(F.ws + WS_SCML); const float* BS = (const float*)(F.ws + WS_SCBS);
    float* STC = (float*)(F.ws + WS_STC); float* STN = (float*)(F.ws + WS_STN); float* STM = (float*)(F.ws + WS_STM);
    for (int e = gid; e < 8 * 16384; e += NT) {
        const int seq = e >> 14, el = e & 16383;
        const float* up = U + (size_t)(seq * 32) * 16384 + el; float* sp = STC + (size_t)(seq * 32) * 16384 + el;
        float u[31];
#pragma unroll
        for (int j = 0; j < 31; ++j) u[j] = up[(size_t)j * 16384];
        float c = 0.f, m = 0.f;
#pragma unroll
        for (int j = 0; j < 32; ++j) {
            sp[(size_t)j * 16384] = c;
            if (el == 0) STM[seq * 32 + j] = m;
            if (j < 31) { const float bsj = BS[seq * 32 + j], mlj = ML[seq * 32 + j]; const float mn = fmaxf(bsj + m, mlj);
                c = __expf(bsj + m - mn) * c + __expf(mlj - mn) * u[j]; m = mn; }
        }
    }
    for (int e = gid; e < 8 * 128; e += NT) {
        const int seq = e >> 7, el = e & 127;
        float c = 0.f, m = 0.f;
        for (int j = 0; j < 32; ++j) {
            STN[(seq * 32 + j) * 128 + el] = c;
            if (j < 31) { const float bsj = BS[seq * 32 + j], mlj = ML[seq * 32 + j]; const float mn = fmaxf(bsj + m, mlj);
                c = __expf(bsj + m - mn) * c + __expf(mlj - mn) * NU[(seq * 32 + j) * 128 + el]; m = mn; }
        }
    }
    const float* C1P = (const float*)(F.ws + WS_C1P); const float* C2P = (const float*)(F.ws + WS_C2P);
    float* C1 = (float*)(F.ws + WS_C1); float* C2 = (float*)(F.ws + WS_C2);
    for (int n = gid; n < FF; n += NT) { float s1 = 0.f, s2 = 0.f;
#pragma unroll
        for (int kb = 0; kb < 16; ++kb) { s1 += C1P[kb * FF + n]; s2 += C2P[kb * FF + n]; }
        C1[n] = s1; C2[n] = s2 + bff1[n]; }
}

constexpr int M3_Q = 0, M3_K = 16384, M3_V = 32768, M3_KW = 49152, M3_C = 65536, M3_S = 98304, M3_H = 0;
__device__ __forceinline__ void mlstm_stage3_item(Frame& F, const Args& A, int item) {
    const int tid = F.tid, lane = F.lane, wid = F.wave, r32 = lane & 31, hi = lane >> 5;
    const bf16* QB = (const bf16*)(F.ws + WS_QB); const bf16* KB = (const bf16*)(F.ws + WS_KB); const bf16* VB = (const bf16*)(F.ws + WS_VB); const bf16* OG = (const bf16*)(F.ws + WS_OG);
    const float* IG = (const float*)(F.ws + WS_IG); const float* LFp = (const float*)(F.ws + WS_LF);
    bf16* MIX = (bf16*)(F.ws + WS_MIX);
    const float* gn = A.in[10];
    int h, nch; long row0; const float* C0; const float* N0; float m0; bool zero_init = false;
    float* Cout; float* Nout; float* Mout; bool last;
    if (item < 256) {
        const int seq = item >> 5, j = item & 31, b = seq >> 2; h = seq & 3; row0 = (long)b * SEQ + (long)j * 512; nch = 8;
        C0 = (const float*)(F.ws + WS_STC) + (size_t)item * 16384; N0 = (const float*)(F.ws + WS_STN) + item * 128; m0 = ((const float*)(F.ws + WS_STM))[item];
        zero_init = (j == 0); last = (j == 31);
        Cout = F.out + O_CP + (size_t)seq * 16384; Nout = F.out + O_NP + seq * 128; Mout = F.out + O_MP + seq;
    } else {
        const int s = item - 256, db = s >> 2; h = s & 3; row0 = MP + (long)db * 64; nch = 1;
        C0 = A.in[4] + (size_t)s * 16384; N0 = A.in[5] + s * 128; m0 = A.in[6][s]; last = true;
        Cout = F.out + O_CS + (size_t)s * 16384; Nout = F.out + O_NS + s * 128; Mout = F.out + O_MS + s;
    }
    LAS unsigned char* lds = F.lds;
    LAS float* sa = (LAS float*)(lds + M3_S);
    LAS float* smu = sa + 64; LAS float* sg = sa + 128; LAS float* swe = sa + 192; LAS float* senm = sa + 256;
    LAS float* srs = sa + 320; LAS float* snq = sa + 384; LAS float* sinv = sa + 448; LAS float* sn = sa + 512;
    LAS float* sdec = sa + 640;
    const int kb = wid >> 1, vb0 = 2 * (wid & 1);
    const int th = wid >> 2, vq = wid & 3;
    const int trb = tr_read_base(lane);
    f32x16 cacc[2];
#pragma unroll
    for (int vi = 0; vi < 2; ++vi) { const int v = 32 * (vb0 + vi) + r32;
#pragma unroll
        for (int g4 = 0; g4 < 4; ++g4) { f32x4 x = (f32x4){0.f, 0.f, 0.f, 0.f}; if (!zero_init) x = *(const f32x4*)(C0 + v * 128 + 32 * kb + 8 * g4 + 4 * hi);
            cacc[vi][4 * g4] = x[0]; cacc[vi][4 * g4 + 1] = x[1]; cacc[vi][4 * g4 + 2] = x[2]; cacc[vi][4 * g4 + 3] = x[3];
            *(LAS v2u*)(lds + M3_C + (4 * kb + g4) * 2048 + v * 16 + hi * 8) = (v2u){pk2(x[0], x[1]), pk2(x[2], x[3])}; } }
    if (tid < 128) sn[tid] = zero_init ? 0.f : N0[tid];
    float mrun = zero_init ? 0.f : m0;
    __syncthreads();
    for (int c = 0; c < nch; ++c) {
        const long rowc = row0 + c * 64;
        v4u qv[2], kv[2], vv[2];
#pragma unroll
        for (int i = 0; i < 2; ++i) { const int p = tid + 512 * i, row = p >> 4, c16 = p & 15; const size_t off = (size_t)(rowc + row) * AW + h * 128 + c16 * 8;
            qv[i] = *(const v4u*)(QB + off); kv[i] = *(const v4u*)(KB + off); vv[i] = *(const v4u*)(VB + off); }
        if (wid == 0) {
            const float lfv = LFp[(rowc + lane) * 4 + h], igv = IG[(rowc + lane) * 4 + h];
            float bs = lfv;
#pragma unroll
            for (int off = 1; off < 64; off <<= 1) { const float t = __shfl_up(bs, off); if (lane >= off) bs += t; }
            const float a = igv - bs;
            float pm = a;
#pragma unroll
            for (int off = 1; off < 64; off <<= 1) { const float t = __shfl_up(pm, off); if (lane >= off) pm = fmaxf(pm, t); }
            const float mu = fmaxf(mrun, pm), g = __expf(mrun - mu);
            const float muL = __shfl(mu, 63), bL = __shfl(bs, 63);
            sa[lane] = a; smu[lane] = mu; sg[lane] = g; swe[lane] = __expf(a - muL); senm[lane] = __expf(-(bs + mu));
            if (lane == 0) sdec[0] = __expf(mrun - muL);
            mrun = bL + muL;
        }
#pragma unroll
        for (int i = 0; i < 2; ++i) { const int p = tid + 512 * i, row = p >> 4, c16 = p & 15;
            *(LAS v4u*)(lds + M3_Q + c16 * 1024 + row * 16) = qv[i]; *(LAS v4u*)(lds + M3_K + c16 * 1024 + row * 16) = kv[i]; *(LAS v4u*)(lds + M3_V + tr_off(row, c16)) = vv[i]; }
        __syncthreads();
#pragma unroll
        for (int i = 0; i < 2; ++i) { const int p = tid + 512 * i, row = p >> 4, c16 = p & 15; *(LAS v4u*)(lds + M3_KW + tr_off(row, c16)) = scale8(kv[i], swe[row]); }
        { const int t = tid >> 3, part = tid & 7; float s = 0.f;
#pragma unroll
          for (int cc = 0; cc < 2; ++cc) { const int ch = 2 * part + cc; const v4u q8 = *(const LAS v4u*)(lds + M3_Q + ch * 1024 + t * 16);
              const f32x4 n0 = *(const LAS f32x4*)(sn + ch * 8), n1 = *(const LAS f32x4*)(sn + ch * 8 + 4);
              s += bflo(q8.x) * n0[0] + bfhi(q8.x) * n0[1] + bflo(q8.y) * n0[2] + bfhi(q8.y) * n0[3] + bflo(q8.z) * n1[0] + bfhi(q8.z) * n1[1] + bflo(q8.w) * n1[2] + bfhi(q8.w) * n1[3]; }
          s += __shfl_xor(s, 1); s += __shfl_xor(s, 2); s += __shfl_xor(s, 4);
          if (part == 0) snq[t] = s; }
        bf16x8 qf[8];
#pragma unroll
        for (int d0 = 0; d0 < 8; ++d0) qf[d0] = *(const LAS bf16x8*)(lds + M3_Q + (2 * d0 + hi) * 1024 + (32 * th + r32) * 16);
        v4u pw[4]; float rs = 0.f;
        const int tt = 32 * th + r32; const float mut = smu[tt];
#pragma unroll
        for (int sh = 0; sh < 2; ++sh) {
            f32x16 p;
#pragma unroll
            for (int r = 0; r < 16; ++r) p[r] = 0.f;
#pragma unroll
            for (int d0 = 0; d0 < 8; ++d0) { const bf16x8 kf = *(const LAS bf16x8*)(lds + M3_K + (2 * d0 + hi) * 1024 + (32 * sh + r32) * 16);
                p = __builtin_amdgcn_mfma_f32_32x32x16_bf16(kf, qf[d0], p, 0, 0, 0); }
#pragma unroll
            for (int g4 = 0; g4 < 4; ++g4) { const f32x4 av = *(const LAS f32x4*)(sa + 32 * sh + 8 * g4 + 4 * hi);
#pragma unroll
                for (int e = 0; e < 4; ++e) { const int s = 32 * sh + 8 * g4 + 4 * hi + e; const float w = (s <= tt) ? __expf(av[e] - mut) : 0.f; const float x = p[4 * g4 + e] * w; p[4 * g4 + e] = x; rs += x; } }
            pw[2 * sh] = (v4u){cvt_pk_bf16(p[0], p[1]), cvt_pk_bf16(p[2], p[3]), cvt_pk_bf16(p[4], p[5]), cvt_pk_bf16(p[6], p[7])};
            pw[2 * sh + 1] = (v4u){cvt_pk_bf16(p[8], p[9]), cvt_pk_bf16(p[10], p[11]), cvt_pk_bf16(p[12], p[13]), cvt_pk_bf16(p[14], p[15])};
        }
        rs = swap_add(rs);
        if (vq == 0 && hi == 0) srs[tt] = rs;
        f32x16 num;
#pragma unroll
        for (int r = 0; r < 16; ++r) num[r] = 0.f;
#pragma unroll
        for (int d0 = 0; d0 < 8; ++d0) { const bf16x8 cf = *(const LAS bf16x8*)(lds + M3_C + (2 * d0 + hi) * 2048 + (32 * vq + r32) * 16);
            num = __builtin_amdgcn_mfma_f32_32x32x16_bf16(qf[d0], cf, num, 0, 0, 0); }
#pragma unroll
        for (int g4 = 0; g4 < 4; ++g4) { const f32x4 gv = *(const LAS f32x4*)(sg + 32 * th + 8 * g4 + 4 * hi);
#pragma unroll
            for (int e = 0; e < 4; ++e) num[4 * g4 + e] *= gv[e]; }
#pragma unroll
        for (int ks = 0; ks < 4; ++ks) { const bf16x8 vf = trfrag(lds + M3_V + vq * 4096 + ks * 1024 + trb);
            num = __builtin_amdgcn_mfma_f32_32x32x16_bf16(__builtin_bit_cast(bf16x8, pw[ks]), vf, num, 0, 0, 0); }
        __syncthreads();
        if (tid < 64) { const float den = sg[tid] * snq[tid] + srs[tid]; sinv[tid] = 1.0f / fmaxf(fabsf(den), senm[tid]); }
        const float decay = sdec[0];
#pragma unroll
        for (int vi = 0; vi < 2; ++vi)
#pragma unroll
            for (int r = 0; r < 16; ++r) cacc[vi][r] *= decay;
#pragma unroll
        for (int ks = 0; ks < 4; ++ks) { const bf16x8 af = trfrag(lds + M3_KW + kb * 4096 + ks * 1024 + trb);
#pragma unroll
            for (int vi = 0; vi < 2; ++vi) { const bf16x8 bfr = trfrag(lds + M3_V + (vb0 + vi) * 4096 + ks * 1024 + trb);
                cacc[vi] = __builtin_amdgcn_mfma_f32_32x32x16_bf16(af, bfr, cacc[vi], 0, 0, 0); } }
        if (tid < 128) { const int k = tid; float s = 0.f;
#pragma unroll 8
            for (int sidx = 0; sidx < 64; ++sidx) { const unsigned short w = *(const LAS unsigned short*)(lds + M3_KW + (k >> 5) * 4096 + (sidx >> 4) * 1024 + (sidx & 15) * 64 + (k & 31) * 2); s += __builtin_bit_cast(float, (unsigned)w << 16); }
            sn[k] = decay * sn[k] + s; }
        __syncthreads();
#pragma unroll
        for (int g4 = 0; g4 < 4; ++g4) { const f32x4 iv = *(const LAS f32x4*)(sinv + 32 * th + 8 * g4 + 4 * hi);
#pragma unroll
            for (int e = 0; e < 4; ++e) { const int t = 32 * th + 8 * g4 + 4 * hi + e; *(LAS float*)(lds + M3_H + (t * 128 + 32 * vq + r32) * 4) = num[4 * g4 + e] * iv[e]; } }
#pragma unroll
        for (int vi = 0; vi < 2; ++vi) { const int v = 32 * (vb0 + vi) + r32;
#pragma unroll
            for (int g4 = 0; g4 < 4; ++g4) *(LAS v2u*)(lds + M3_C + (4 * kb + g4) * 2048 + v * 16 + hi * 8) = (v2u){pk2(cacc[vi][4 * g4], cacc[vi][4 * g4 + 1]), pk2(cacc[vi][4 * g4 + 2], cacc[vi][4 * g4 + 3])}; }
        __syncthreads();
        { const int t = tid >> 3, part = tid & 7; f32x4 x[4]; float s = 0.f;
#pragma unroll
          for (int i = 0; i < 4; ++i) { x[i] = *(const LAS f32x4*)(lds + M3_H + (t * 128 + part * 16 + 4 * i) * 4); s += (x[i][0] + x[i][1]) + (x[i][2] + x[i][3]); }
          s += __shfl_xor(s, 1); s += __shfl_xor(s, 2); s += __shfl_xor(s, 4);
          const float mean = s * (1.f / 128.f); float q = 0.f;
#pragma unroll
          for (int i = 0; i < 4; ++i) { x[i] = x[i] - mean; q += (x[i][0] * x[i][0] + x[i][1] * x[i][1]) + (x[i][2] * x[i][2] + x[i][3] * x[i][3]); }
          q += __shfl_xor(q, 1); q += __shfl_xor(q, 2); q += __shfl_xor(q, 4);
          const float rstd = 1.0f / sqrtf(q * (1.f / 128.f) + LN_EPS);
          const size_t orow = (size_t)(rowc + t);
          const v4u og0 = *(const v4u*)(OG + orow * AW + h * 128 + part * 16), og1 = *(const v4u*)(OG + orow * AW + h * 128 + part * 16 + 8);
          const float* gp = gn + h * 128 + part * 16;
          const f32x4 g0 = *(const f32x4*)gp, g1 = *(const f32x4*)(gp + 4), g2 = *(const f32x4*)(gp + 8), g3 = *(const f32x4*)(gp + 12);
          v4u o0, o1;
          o0.x = pk2(x[0][0] * rstd * g0[0] * bflo(og0.x), x[0][1] * rstd * g0[1] * bfhi(og0.x)); o0.y = pk2(x[0][2] * rstd * g0[2] * bflo(og0.y), x[0][3] * rstd * g0[3] * bfhi(og0.y));
          o0.z = pk2(x[1][0] * rstd * g1[0] * bflo(og0.z), x[1][1] * rstd * g1[1] * bfhi(og0.z)); o0.w = pk2(x[1][2] * rstd * g1[2] * bflo(og0.w), x[1][3] * rstd * g1[3] * bfhi(og0.w));
          o1.x = pk2(x[2][0] * rstd * g2[0] * bflo(og1.x), x[2][1] * rstd * g2[1] * bfhi(og1.x)); o1.y = pk2(x[2][2] * rstd * g2[2] * bflo(og1.y), x[2][3] * rstd * g2[3] * bfhi(og1.y));
          o1.z = pk2(x[3][0] * rstd * g3[0] * bflo(og1.z), x[3][1] * rstd * g3[1] * bfhi(og1.z)); o1.w = pk2(x[3][2] * rstd * g3[2] * bflo(og1.w), x[3][3] * rstd * g3[3] * bfhi(og1.w));
          bf16* mp = MIX + orow * DM + 512 + h * 128 + part * 16;
          *(v4u*)mp = o0; *(v4u*)(mp + 8) = o1; }
        __syncthreads();
    }
    if (last) {
#pragma unroll
        for (int vi = 0; vi < 2; ++vi) { const int v = 32 * (vb0 + vi) + r32;
#pragma unroll
            for (int g4 = 0; g4 < 4; ++g4) *(f32x4*)(Cout + v * 128 + 32 * kb + 8 * g4 + 4 * hi) = (f32x4){cacc[vi][4 * g4], cacc[vi][4 * g4 + 1], cacc[vi][4 * g4 + 2], cacc[vi][4 * g4 + 3]}; }
        if (tid < 128) Nout[tid] = sn[tid];
        if (tid == 0) Mout[0] = mrun;
    }
    __syncthreads();
}

__device__ __forceinline__ void p8_final_ln(Frame& F, const float* g2, const float* b2) {
    const int gw = F.vcu * 8 + F.wave, NGW = F.G * 8;
    f32x4 gg[4], bb[4];
#pragma unroll
    for (int j = 0; j < 4; ++j) { gg[j] = *(const f32x4*)(g2 + 256 * j + 4 * F.lane); bb[j] = *(const f32x4*)(b2 + 256 * j + 4 * F.lane); }
    for (int m = gw; m < MT; m += NGW) {
        GAS f32x4* xr = (GAS f32x4*)(F.out + (size_t)m * DM) + F.lane;
        f32x4 v[4]; float s = 0.f;
#pragma unroll
        for (int j = 0; j < 4; ++j) { v[j] = xr[64 * j]; s += (v[j][0] + v[j][1]) + (v[j][2] + v[j][3]); }
        const float mean = wave_sum(s) * (1.f / DM); float s2 = 0.f;
#pragma unroll
        for (int j = 0; j < 4; ++j) { v[j] = v[j] - mean; s2 += (v[j][0] * v[j][0] + v[j][1] * v[j][1]) + (v[j][2] * v[j][2] + v[j][3] * v[j][3]); }
        const float rstd = 1.f / sqrtf(wave_sum(s2) * (1.f / DM) + LN_EPS);
#pragma unroll
        for (int j = 0; j < 4; ++j) xr[64 * j] = v[j] * rstd * gg[j] + bb[j];
    }
}

#define XB_TMO      128
#define XB_XCNT(j)  (256  + 64 * (j))
#define XB_XSUB(j)  (1280 + 64 * (j))
#define XB_XGEN(j)  (2304 + 64 * (j))
#define XB_TOP      3328
#define XB_TOPGEN   3392
#define XCD_BAR_WORDS 3456
#define XB_SPIN_CAP (1u << 18)
__device__ __forceinline__ unsigned xb_ld(unsigned* p)              { return __hip_atomic_load(p, __ATOMIC_RELAXED, __HIP_MEMORY_SCOPE_AGENT); }
__device__ __forceinline__ unsigned xb_add(unsigned* p, unsigned v) { return __hip_atomic_fetch_add(p, v, __ATOMIC_RELAXED, __HIP_MEMORY_SCOPE_AGENT); }
__device__ __forceinline__ unsigned xb_xcc_id() { return (unsigned)__builtin_amdgcn_s_getreg((3 << 11) | 20) & 0xFu; }
#define XB_SPIN(cond, bar) do { unsigned _sp = 0; while (cond) { __builtin_amdgcn_s_sleep(1); \
    if ((++_sp & 255u) == 0u) { if (xb_ld(&(bar)[XB_TMO])) break; if (_sp > XB_SPIN_CAP) { atomicAdd(&(bar)[XB_TMO], 1u); break; } } } } while (0)
struct XcdBarrier { unsigned* bar; unsigned x; volatile LAS unsigned* st; };
__device__ __forceinline__ XcdBarrier xcd_barrier_post(unsigned* bar, volatile LAS unsigned* st) {
    XcdBarrier b; b.bar = bar; b.x = xb_xcc_id(); b.st = st;
    if (threadIdx.x == 0) (void)xb_add(&bar[XB_XCNT(b.x)], 1u);
    return b;
}
__device__ __forceinline__ void xcd_barrier_complete(unsigned* bar, unsigned x, unsigned& nloc, unsigned& nx) {
    const unsigned G = gridDim.x * gridDim.y * gridDim.z;
    unsigned sum, cnt, mine, sp = 0u;
    for (;;) {
        sum = 0u; cnt = 0u; mine = 0u;
#pragma unroll
        for (unsigned j = 0; j < 16; ++j) { const unsigned c = xb_ld(&bar[XB_XCNT(j)]); sum += c; cnt += (c > 0u) ? 1u : 0u; mine = (j == x) ? c : mine; }
        if (sum == G) break;
        __builtin_amdgcn_s_sleep(1);
        if ((++sp & 255u) == 0u) { if (xb_ld(&bar[XB_TMO])) break; if (sp > XB_SPIN_CAP) { atomicAdd(&bar[XB_TMO], 1u); break; } }
    }
    nloc = mine > 0u ? mine : 1u; nx = cnt > 0u ? cnt : 1u;
}
__device__ __forceinline__ void xcd_barrier(const XcdBarrier& b) {
    asm volatile("s_waitcnt vmcnt(0)" ::: "memory");
    __syncthreads();
    if (threadIdx.x == 0) {
        unsigned* bar = b.bar;
        __builtin_amdgcn_s_waitcnt(0);
        unsigned nloc = b.st[0], nx = b.st[1];
        if (nloc == 0u) { xcd_barrier_complete(bar, b.x, nloc, nx); b.st[0] = nloc; b.st[1] = nx; }
        const unsigned old = xb_add(&bar[XB_XSUB(b.x)], 1u);
        const unsigned gen = old / nloc;
        if (old + 1u == (gen + 1u) * nloc) {
            __builtin_amdgcn_fence(__ATOMIC_RELEASE, "agent");
            asm volatile("s_waitcnt vmcnt(0)" ::: "memory");
            const unsigned og = xb_add(&bar[XB_TOP], 1u);
            const unsigned tg = og / nx;
            if (og + 1u == (tg + 1u) * nx) xb_add(&bar[XB_TOPGEN], 1u);
            else XB_SPIN(xb_ld(&bar[XB_TOPGEN]) == tg, bar);
            __builtin_amdgcn_fence(__ATOMIC_ACQUIRE, "agent");
            xb_add(&bar[XB_XGEN(b.x)], 1u);
            asm volatile("s_waitcnt vmcnt(0)" ::: "memory");
        } else {
            XB_SPIN(xb_ld(&bar[XB_XGEN(b.x)]) == gen, bar);
            __builtin_amdgcn_fence(__ATOMIC_ACQUIRE, "agent");
            asm volatile("s_waitcnt vmcnt(0)" ::: "memory");
        }
    }
    __syncthreads();
}

constexpr int N_PHASES = 9;

__global__ void __launch_bounds__(512, 2) hybrid_fwd(Args args) {
    extern __shared__ __attribute__((aligned(16))) unsigned char lds_raw[];
    Frame F;
    F.lds = (LAS unsigned char*)lds_raw;
    F.tid = threadIdx.x; F.lane = F.tid & 63; F.wave = __builtin_amdgcn_readfirstlane(F.tid >> 6);
    F.G = gridDim.x; { const int bx = blockIdx.x; F.vcu = (F.G % 8 == 0) ? (bx % 8) * (F.G / 8) + bx / 8 : bx; }
    F.out = args.out; F.ws = args.ws;
    const int lo = args.ph_lo, hi = args.ph_hi;
#define IN(k) (lo <= (k) && (k) < hi)
#define BOTH(k) (IN(k) && IN((k) + 1))
#define GRID_BAR() do { xcd_barrier(bar); if (DUP_PHASE == 99) xcd_barrier(bar); } while (0)
    for (int u = F.tid; u < (LDS_BYTES - RING_BYTES) / 4; u += 512) ((LAS unsigned*)(F.lds + RING_BYTES))[u] = 0u;
    __syncthreads();
    XcdBarrier bar; bar.bar = (unsigned*)(F.ws + WS_CTL) + CW_BAR; bar.x = 0; bar.st = nullptr;
    if (hi - lo > 1) bar = xcd_barrier_post((unsigned*)(F.ws + WS_CTL) + CW_BAR, (volatile LAS unsigned*)(F.lds + MISC_OFF) + 8);

    if (IN(0)) { p0_prologue(F, args); if (DUP_PHASE == 10) { __syncthreads(); p0_prologue(F, args); } if (BOTH(0)) GRID_BAR(); }

    if (IN(1)) {
        pg8::Gemm g{(const bf16*)(F.ws + WS_XB), (const bf16*)(F.ws + WS_WIN), MP, NIN, DM}; pg8::StaticOrder S; S.init(MP, NIN, F.G, (int)blockIdx.x);
        EpiInProj E; E.ws = F.ws; E.bias = args.in[8];
        static_assert(WS_KA == WS_QA + 33 * MiB && WS_VA == WS_QA + 70 * MiB && WS_QB == WS_QA + 107 * MiB && WS_KB == WS_QA + 140 * MiB && WS_VB == WS_QA + 173 * MiB && WS_OG == WS_QA + 206 * MiB, "slice map");
        E.out = F.out;
        pg8::gemm_phase<EpiInProj, pg8::StaticOrder, true, true>(F.lds, g, S, E);
        if (DUP_PHASE == 1) pg8::gemm_phase<EpiInProj, pg8::StaticOrder, true, true>(F.lds, g, S, E);
        { SEpiInProj SE{F.ws, args.in[8], F.out};
          for (int rep = 0; rep < (DUP_PHASE == 11 ? 2 : 1); ++rep) small_gemm_phase(F, (const bf16*)(F.ws + WS_XB) + (size_t)MP * DM, (const bf16*)(F.ws + WS_WIN), NIN, DM, SE); }
        if (BOTH(1)) GRID_BAR();
    }

    if (IN(2)) {
        const bf16* QA = (const bf16*)(F.ws + WS_QA); const bf16* KA = (const bf16*)(F.ws + WS_KA); const bf16* VA = (const bf16*)(F.ws + WS_VA); bf16* MIX = (bf16*)(F.ws + WS_MIX);
        for (int rep = 0; rep < (DUP_PHASE == 20 ? 2 : 1); ++rep) {
        for (int id = F.vcu * 4; id < 1024; id += F.G * 4)
            for (int k = 0; k < 4; ++k) { const int uid = id + k, bh = uid >> 6, qb = uid & 63, b = bh >> 3, h = bh & 7;
                const int ilo = (8 - 4 * qb) > 0 ? (8 - 4 * qb) : 0;
                attn_unit(F, QA, KA, VA, MIX, args.in[9], h, (long)b * SEQ + 256 * qb, (long)b * SEQ + 64 * (4 * qb - 8), ilo, 11, 8); }
        for (int uid = F.vcu; uid < 64; uid += F.G) { const int db = uid >> 3, h = uid & 7;
            attn_unit(F, QA, KA, VA, MIX, args.in[9], h, (long)MP + 64 * db, (long)MP + 576 * db, 0, 8, 2); }
        }
        for (int rep = 0; rep < (DUP_PHASE == 21 ? 2 : 1); ++rep)
        for (int it = F.vcu; it < 256; it += F.G) mlstm_stage1_item(F, it);
        if (BOTH(2)) GRID_BAR();
    }

    if (IN(3)) { p3_scan(F, args.in[15]); if (DUP_PHASE == 3) p3_scan(F, args.in[15]); if (BOTH(3)) GRID_BAR(); }

    if (IN(4)) { for (int rep = 0; rep < (DUP_PHASE == 4 ? 2 : 1); ++rep) for (int it = F.vcu; it < 288; it += F.G) mlstm_stage3_item(F, args, it); if (BOTH(4)) GRID_BAR(); }

    if (IN(5)) {
        pg8::Gemm g{(const bf16*)(F.ws + WS_MIX), (const bf16*)(F.ws + WS_WOUT), MP, DM, DM}; pg8::StaticOrder S; S.init(MP, DM, F.G, (int)blockIdx.x);
        EpiZ1 E{args.in[0], args.in[1], (bf16*)(F.ws + WS_Z1), (float*)(F.ws + WS_STAT1), true};
        pg8::gemm_phase<EpiZ1, pg8::StaticOrder, true, true>(F.lds, g, S, E);
        if (DUP_PHASE == 5) { E.do_stat = false; pg8::gemm_phase<EpiZ1, pg8::StaticOrder, true, true>(F.lds, g, S, E); }
        { SEpiZ1 SE{args.in[1], (bf16*)(F.ws + WS_Z1), (float*)(F.ws + WS_STAT1)};
          small_gemm_phase(F, (const bf16*)(F.ws + WS_MIX) + (size_t)MP * DM, (const bf16*)(F.ws + WS_WOUT), DM, DM, SE); }
        if (BOTH(5)) GRID_BAR();
    }

    if (IN(6)) {
        pg8::Gemm g{(const bf16*)(F.ws + WS_Z1), (const bf16*)(F.ws + WS_W1), MP, FF, DM}; pg8::StaticOrder S; S.init(MP, FF, F.G, (int)blockIdx.x);
        EpiFfn1 E{(const float*)(F.ws + WS_STAT1), (const float*)(F.ws + WS_C1), (const float*)(F.ws + WS_C2), (bf16*)(F.ws + WS_HID)};
        pg8::gemm_phase<EpiFfn1, pg8::StaticOrder, true, true>(F.lds, g, S, E);
        if (DUP_PHASE == 6) pg8::gemm_phase<EpiFfn1, pg8::StaticOrder, true, true>(F.lds, g, S, E);
        { SEpiFfn1 SE{(const float*)(F.ws + WS_STAT1), (const float*)(F.ws + WS_C1), (const float*)(F.ws + WS_C2), (bf16*)(F.ws + WS_HID)};
          for (int rep = 0; rep < (DUP_PHASE == 16 ? 2 : 1); ++rep) small_gemm_phase(F, (const bf16*)(F.ws + WS_Z1) + (size_t)MP * DM, (const bf16*)(F.ws + WS_W1), FF, DM, SE); }
        if (BOTH(6)) GRID_BAR();
    }

    if (IN(7)) {
        pg8::Gemm g{(const bf16*)(F.ws + WS_HID), (const bf16*)(F.ws + WS_W2), MP, DM, FF}; pg8::StaticOrder S; S.init(MP, DM, F.G, (int)blockIdx.x);
        EpiFfn2 E{(const float*)(F.ws + WS_STAT1), (const bf16*)(F.ws + WS_Z1), args.in[12], args.in[13], args.in[17], F.out};
        pg8::gemm_phase<EpiFfn2, pg8::StaticOrder, true, true>(F.lds, g, S, E);
        if (DUP_PHASE == 7) pg8::gemm_phase<EpiFfn2, pg8::StaticOrder, true, true>(F.lds, g, S, E);
        { SEpiFfn2 SE{(const float*)(F.ws + WS_STAT1), (const bf16*)(F.ws + WS_Z1), args.in[12], args.in[13], args.in[17], F.out};
          for (int rep = 0; rep < (DUP_PHASE == 17 ? 2 : 1); ++rep) small_gemm_phase(F, (const bf16*)(F.ws + WS_HID) + (size_t)MP * FF, (const bf16*)(F.ws + WS_W2), DM, FF, SE); }
        if (BOTH(7)) GRID_BAR();
    }

    if (IN(8)) { p8_final_ln(F, args.in[18], args.in[19]); }
#undef IN
#undef BOTH
#undef GRID_BAR
}

extern "C" void kernel_launch(void* const* d_in, const int* in_sizes, int n_in, void* d_out, int out_size, void* d_ws, size_t ws_size, hipStream_t stream) {
    static int grid = 0;
    if (grid == 0) {
        if (n_in != 20 || out_size != (int)O_END || ws_size < WS_END) { fprintf(stderr, "kernel_launch: unexpected shapes: n_in %d out %d ws %zu (need %zu)\n", n_in, out_size, ws_size, (size_t)WS_END); grid = -1; return; }
        int dev = 0, cus = 0, per_cu = 0;
        if (hipGetDevice(&dev) != hipSuccess || hipDeviceGetAttribute(&cus, hipDeviceAttributeMultiprocessorCount, dev) != hipSuccess) { grid = -1; return; }
        if (hipFuncSetAttribute((const void*)hybrid_fwd, hipFuncAttributeMaxDynamicSharedMemorySize, LDS_BYTES) != hipSuccess) { fprintf(stderr, "kernel_launch: hipFuncSetAttribute failed\n"); grid = -1; return; }
        if (hipOccupancyMaxActiveBlocksPerMultiprocessor(&per_cu, (const void*)hybrid_fwd, 512, LDS_BYTES) != hipSuccess || per_cu < 1) { fprintf(stderr, "kernel_launch: occupancy query says %d\n", per_cu); (void)hipGetLastError(); grid = -1; return; }
        grid = cus;
    }
    if (grid < 0) return;
    if (hipMemsetAsync((char*)d_ws + WS_CTL, 0, CTL_ZERO_BYTES, stream) != hipSuccess) { fprintf(stderr, "kernel_launch: hipMemsetAsync failed\n"); return; }
    Args a{};
    for (int i = 0; i < 20; ++i) a.in[i] = (const float*)d_in[i];
    a.out = (float*)d_out; a.ws = (unsigned char*)d_ws;
#if MK_N_LAUNCHES == 1
    a.ph_lo = 0; a.ph_hi = N_PHASES; a.coop = 1;
    void* kargs[] = {&a};
    hipError_t e = hipLaunchCooperativeKernel((const void*)hybrid_fwd, dim3(grid), dim3(512), kargs, LDS_BYTES, stream);
    if (e != hipSuccess) fprintf(stderr, "kernel_launch: cooperative launch failed: %s (grid %d)\n", hipGetErrorString(e), grid);
#else
    for (int p = 0; p < N_PHASES; ++p) {
        a.ph_lo = p; a.ph_hi = p + 1; a.coop = 0;
        hipLaunchKernelGGL(hybrid_fwd, dim3(grid), dim3(512), LDS_BYTES, stream, a);
    }
#endif
}
```

```cpp
#include <hip/hip_runtime.h>
#include <hip/hip_cooperative_groups.h>
#include <cstdio>
#include <cstdint>
namespace cg = cooperative_groups;

#ifndef MK_N_LAUNCHES
#define MK_N_LAUNCHES 1
#endif
#ifndef DUP_PHASE
#define DUP_PHASE 0
#endif

constexpr int DM = 1024, SEQ = 16384, NB = 2, DB = 8, DSEQ = 64;
constexpr int MP = NB * SEQ;
constexpr int MS = DB * DSEQ;
constexpr int MT = MP + MS;
constexpr int INW = 3592, NIN = 3584;
constexpr int AW = 512;
constexpr int FF = 4096;
constexpr int KVROWS = MP + DB * 576;
constexpr float LN_EPS = 1e-5f;
constexpr float ALPHA = 1.189207115002721f;
constexpr float LOG2E = 1.4426950408889634f;
constexpr float QSCALE = 0.125f * LOG2E;
constexpr float KBSCALE = 0.08838834764831845f;
constexpr size_t O_YP = 0, O_YS = 33554432, O_KP = 34078720, O_VP = 34603008, O_CP = 35127296, O_NP = 35258368, O_MP = 35259392,
                 O_KS = 35259400, O_VS = 35521544, O_CS = 35783688, O_NS = 36307976, O_MS = 36312072, O_END = 36312104;

constexpr size_t MiB = 1u << 20, KiB = 1024;
constexpr size_t WS_CTL = 0, CTL_ZERO_BYTES = 1 * MiB;
constexpr size_t WS_IG = 1 * MiB;
constexpr size_t WS_LF = 1 * MiB + 768 * KiB;
constexpr size_t WS_STAT1 = 2 * MiB + 512 * KiB;
constexpr size_t WS_C1P = 3 * MiB;
constexpr size_t WS_C2P = 3 * MiB + 256 * KiB;
constexpr size_t WS_C1 = 3 * MiB + 512 * KiB;
constexpr size_t WS_C2 = 3 * MiB + 528 * KiB;
constexpr size_t WS_SCNU = 3 * MiB + 768 * KiB;
constexpr size_t WS_STN = 3 * MiB + 896 * KiB;
constexpr size_t WS_SCML = 4 * MiB;
constexpr size_t WS_SCBS = 4 * MiB + 4 * KiB;
constexpr size_t WS_STM = 4 * MiB + 8 * KiB;
constexpr size_t WS_SCU = 5 * MiB;
constexpr size_t WS_STC = 21 * MiB;
constexpr size_t WS_WIN = 37 * MiB, WS_WOUT = 44 * MiB, WS_W1 = 46 * MiB, WS_W2 = 54 * MiB;
constexpr size_t WS_XB = 62 * MiB;
constexpr size_t WS_QA = 127 * MiB;
constexpr size_t WS_KA = WS_QA + 33 * MiB;
constexpr size_t WS_VA = WS_KA + 37 * MiB;
constexpr size_t WS_QB = WS_VA + 37 * MiB;
constexpr size_t WS_KB = WS_QB + 33 * MiB;
constexpr size_t WS_VB = WS_KB + 33 * MiB;
constexpr size_t WS_OG = WS_VB + 33 * MiB;
constexpr size_t WS_HID = 62 * MiB;
constexpr size_t WS_MIX = WS_OG + 33 * MiB;
constexpr size_t WS_Z1 = WS_MIX + 65 * MiB;
constexpr size_t WS_END = WS_Z1 + 65 * MiB;
static_assert(WS_HID + (size_t)MT * FF * 2 <= WS_OG, "HID overlay must not reach OG/MIX");
static_assert(WS_END <= 512 * MiB, "workspace map");
constexpr int CW_BAR = 4096;

constexpr int RING_BYTES = 131072;
constexpr int MISC_OFF = RING_BYTES + 320;
constexpr int LDS_BYTES = 147456;

#define GAS __attribute__((address_space(1)))
#define LAS __attribute__((address_space(3)))
typedef unsigned short bf16;
typedef unsigned v4u __attribute__((ext_vector_type(4)));
typedef unsigned v2u __attribute__((ext_vector_type(2)));
typedef float f32x4 __attribute__((ext_vector_type(4)));
typedef float f32x2 __attribute__((ext_vector_type(2)));
typedef float f32x16 __attribute__((ext_vector_type(16)));
typedef short bf16x8 __attribute__((ext_vector_type(8)));
typedef short s16x4 __attribute__((ext_vector_type(4)));
typedef GAS unsigned gu32;
#define RLX_AGENT __ATOMIC_RELAXED, __HIP_MEMORY_SCOPE_AGENT
#define LDS_WAIT() asm volatile("s_waitcnt lgkmcnt(0)" ::: "memory")
#define VM_WAIT() asm volatile("s_waitcnt vmcnt(0)" ::: "memory")

__device__ __forceinline__ unsigned f2bf(float f) { unsigned u = __builtin_bit_cast(unsigned, f); return (u + 0x7fffu + ((u >> 16) & 1u)) >> 16; }
__device__ __forceinline__ unsigned pk2(float lo, float hi) { return f2bf(lo) | (f2bf(hi) << 16); }
__device__ __forceinline__ float bflo(unsigned w) { return __builtin_bit_cast(float, w << 16); }
__device__ __forceinline__ float bfhi(unsigned w) { return __builtin_bit_cast(float, w & 0xffff0000u); }
__device__ __forceinline__ unsigned cvt_pk_bf16(float lo, float hi) { unsigned r; asm volatile("v_cvt_pk_bf16_f32 %0, %1, %2" : "=v"(r) : "v"(lo), "v"(hi)); return r; }
__device__ __forceinline__ float wave_sum(float v) {
#pragma unroll
    for (int o = 1; o < 64; o <<= 1) v += __shfl_xor(v, o);
    return v;
}
__device__ __forceinline__ int crow(int r, int hi) { return (r & 3) + 8 * (r >> 2) + 4 * hi; }
__device__ __forceinline__ float swap_max(float m) { auto rr = __builtin_amdgcn_permlane32_swap(__float_as_uint(m), __float_as_uint(m), false, false); return fmaxf(__uint_as_float(rr[0]), __uint_as_float(rr[1])); }
__device__ __forceinline__ float swap_add(float m) { auto rr = __builtin_amdgcn_permlane32_swap(__float_as_uint(m), __float_as_uint(m), false, false); return __uint_as_float(rr[0]) + __uint_as_float(rr[1]); }
typedef short v4i16_t __attribute__((ext_vector_type(4)));
__device__ __forceinline__ s16x4 trread(LAS const unsigned char* p) { return __builtin_bit_cast(s16x4, __builtin_amdgcn_ds_read_tr16_b64_v4i16((LAS v4i16_t*)p)); }
__device__ __forceinline__ bf16x8 trfrag(LAS const unsigned char* p) { const s16x4 lo = trread(p), hi = trread(p + 512); return (bf16x8){lo[0], lo[1], lo[2], lo[3], hi[0], hi[1], hi[2], hi[3]}; }

namespace pg8 {
#define PG8_LAS __attribute__((address_space(3)))
typedef unsigned short bf16_t;
typedef unsigned u32x4 __attribute__((ext_vector_type(4)));
constexpr int BM = 256, BK = 64, HALF = 128, HTB = HALF * BK * 2, STAGE_BYTES = 8 * HTB, NXCD = 8, WGM = 8;
__host__ __device__ __forceinline__ int lds_byte(int r, int c) { const int st = (r >> 4) * 2 + (c >> 5), rr = r & 15, cc = c & 31, ob = rr * 64 + cc * 2; return st * 1024 + (ob ^ (((ob >> 9) & 1) << 5)); }
__host__ __device__ __forceinline__ void stage_rc(int b, int& R, int& C) { const int st = b / 1024, sb = b % 1024, swz = sb ^ (((sb >> 9) & 1) << 5); R = (st >> 1) * 16 + swz / 64; C = (st & 1) * 32 + (swz % 64) / 2; }
__host__ __device__ __forceinline__ int perm32(int rho) { const int n = rho >> 4, i = rho & 15; return 8 * (i >> 2) + 4 * n + (i & 3); }
struct Unit { int pm, pn; };
struct Gemm { const bf16_t* A; const bf16_t* Bt; int M, N, K; };
struct StaticOrder {
    int nM, nN, nwg, G, c;
    __host__ __device__ void init(int M, int N, int G_, int c_) { nM = M / BM; nN = N / BM; nwg = nM * nN; G = G_; c = c_; }
    __host__ __device__ bool next(int i, Unit& u) const {
        const long L = (long)i * G + c; if (L >= nwg) return false;
        int wgid = (int)L; { const int q = nwg / NXCD, r = nwg % NXCD, xcd = wgid % NXCD, off = wgid / NXCD; wgid = (xcd < r ? xcd * (q + 1) : r * (q + 1) + (xcd - r) * q) + off; }
        const int nig = WGM * nN, gid = wgid / nig, fm = gid * WGM, gsz = (nM - fm) < WGM ? (nM - fm) : WGM;
        u.pm = fm + ((wgid % nig) % gsz); u.pn = (wgid % nig) / gsz; return true;
    }
    __device__ __forceinline__ void a_ready(const Unit&) const {}
    __device__ __forceinline__ void done(const Unit&) const {}
};

template <class Epi, class Sched, bool ALIGN_EPI = false, bool SP2 = false>
__device__ __forceinline__ void gemm_phase(PG8_LAS unsigned char* lds, const Gemm g, const Sched& S, const Epi& E) {
    const int tid = threadIdx.x, wid = __builtin_amdgcn_readfirstlane(tid >> 6), lane = tid & 63, wr = wid >> 2, wc = wid & 3, fr = lane & 15, fq = lane >> 4;
    const int K = g.K, nt = K / BK;
    unsigned voffA[2], voffB[2];
#pragma unroll
    for (int i = 0; i < 2; ++i) { int R, C; stage_rc(tid * 16 + i * 8192, R, C); const int Rb = Epi::PERM ? ((R & ~31) + perm32(R & 31)) : R;
        voffA[i] = (unsigned)(R * K + C) * 2u; voffB[i] = (unsigned)(Rb * K + C) * 2u; }
    const size_t kstep = (size_t)(BK * 2);
    const size_t hstep = (size_t)HALF * K * 2;
    const size_t tstep = 2 * hstep;
    const unsigned ldsw = (unsigned)wid * 1024u;
    const int aoff = lds_byte(wr * 64 + fr, fq * 8), boff = lds_byte(wc * 32 + fr, fq * 8);
#define PG8_SA(b, h) (((b) * 2 + (h)) * HTB)
#define PG8_SB(b, h) ((4 + (b) * 2 + (h)) * HTB)
#define PG8_STAGE(bufoff, gbase, voff) do { _Pragma("unroll") for (int _i = 0; _i < 2; ++_i) \
        __builtin_amdgcn_global_load_lds((const unsigned*)((const char*)(gbase) + (voff)[_i]), (PG8_LAS unsigned*)(lds + (bufoff) + ldsw + _i * 8192), 16, 0, 0); } while (0)
#define PG8_LDA(dst, b, h) do { _Pragma("unroll") for (int m = 0; m < 4; ++m) _Pragma("unroll") for (int k = 0; k < 2; ++k) dst[m][k] = *(const PG8_LAS bf16x8*)(lds + PG8_SA(b, h) + aoff + m * 2048 + k * 1024); } while (0)
#define PG8_LDB(dst, b, h) do { _Pragma("unroll") for (int n = 0; n < 2; ++n) _Pragma("unroll") for (int k = 0; k < 2; ++k) dst[n][k] = *(const PG8_LAS bf16x8*)(lds + PG8_SB(b, h) + boff + n * 2048 + k * 1024); } while (0)
#define PG8_MMA(ai, bj, At, Bt) do { __builtin_amdgcn_s_setprio(1); _Pragma("unroll") for (int m = 0; m < 4; ++m) _Pragma("unroll") for (int n = 0; n < 2; ++n) _Pragma("unroll") for (int k = 0; k < 2; ++k) \
        acc[ai][bj][m][n] = __builtin_amdgcn_mfma_f32_16x16x32_bf16(Bt[n][k], At[m][k], acc[ai][bj][m][n], 0, 0, 0); __builtin_amdgcn_s_setprio(0); } while (0)
#define PG8_WAIT_V(n) asm volatile("s_waitcnt vmcnt(" #n ")" ::: "memory")
#define PG8_WAIT_L(n) asm volatile("s_waitcnt lgkmcnt(" #n ")" ::: "memory")
#define PG8_BAR __builtin_amdgcn_s_barrier()
#define PG8_SCHED __builtin_amdgcn_sched_barrier(0)
    Unit cur, nxt; int ui = 0;
    if (!S.next(0, cur)) return;
    f32x4 acc[2][2][4][2];
#pragma unroll
    for (int a = 0; a < 2; ++a)
#pragma unroll
        for (int b = 0; b < 2; ++b)
#pragma unroll
            for (int m = 0; m < 4; ++m)
#pragma unroll
                for (int n = 0; n < 2; ++n) acc[a][b][m][n] = (f32x4){0.f, 0.f, 0.f, 0.f};
    bf16x8 At[4][2], B0[2][2], B1[2][2];
    const char* cA = (const char*)g.A + (size_t)cur.pm * tstep; const char* cB = (const char*)g.Bt + (size_t)cur.pn * tstep;
    S.a_ready(cur);
    if constexpr (SP2) {
        PG8_STAGE(PG8_SB(0, 0), cB, voffB); PG8_STAGE(PG8_SB(0, 1), cB + hstep, voffB); PG8_STAGE(PG8_SA(0, 0), cA, voffA); PG8_STAGE(PG8_SA(0, 1), cA + hstep, voffA);
        if (wr == 1) PG8_BAR;
        PG8_WAIT_V(2); PG8_BAR;
        PG8_STAGE(PG8_SB(1, 0), cB + kstep, voffB); PG8_STAGE(PG8_SA(1, 0), cA + kstep, voffA); PG8_STAGE(PG8_SB(1, 1), cB + hstep + kstep, voffB);
        PG8_WAIT_V(6); PG8_BAR;
    } else {
        PG8_STAGE(PG8_SB(0, 0), cB, voffB); PG8_STAGE(PG8_SA(0, 0), cA, voffA); PG8_STAGE(PG8_SB(0, 1), cB + hstep, voffB); PG8_STAGE(PG8_SA(0, 1), cA + hstep, voffA);
        if (wr == 1) PG8_BAR;
        PG8_WAIT_V(4); PG8_BAR;
        PG8_STAGE(PG8_SB(1, 0), cB + kstep, voffB); PG8_STAGE(PG8_SA(1, 0), cA + kstep, voffA); PG8_STAGE(PG8_SB(1, 1), cB + hstep + kstep, voffB);
        PG8_WAIT_V(6); PG8_BAR;
    }
    for (;;) {
        const bool has_next = S.next(ui + 1, nxt);
        const char* nA = has_next ? (const char*)g.A + (size_t)nxt.pm * tstep : cA; const char* nB = has_next ? (const char*)g.Bt + (size_t)nxt.pn * tstep : cB;
        for (int t = 0; t < nt; t += 2) {
            const bool last = (t == nt - 2);
            const char* a1 = cA + (size_t)(t + 1) * kstep;
            const char* a2 = last ? nA : cA + (size_t)(t + 2) * kstep; const char* b2 = last ? nB : cB + (size_t)(t + 2) * kstep;
            const char* a3 = a2 + kstep; const char* b3 = b2 + kstep;
            if (last && has_next) S.a_ready(nxt);
            if constexpr (SP2) {
            PG8_LDB(B0, 0, 0); PG8_LDB(B1, 0, 1); PG8_SCHED; PG8_LDA(At, 0, 0); PG8_STAGE(PG8_SA(1, 1), a1 + hstep, voffA);
            PG8_WAIT_V(8); PG8_WAIT_L(0); PG8_BAR; PG8_MMA(0, 0, At, B0); PG8_MMA(0, 1, At, B1); PG8_BAR; PG8_SCHED;
            PG8_LDA(At, 0, 1); PG8_STAGE(PG8_SB(0, 0), b2, voffB); PG8_STAGE(PG8_SB(0, 1), b2 + hstep, voffB); PG8_STAGE(PG8_SA(0, 0), a2, voffA);
            PG8_WAIT_V(8); PG8_WAIT_L(0); PG8_BAR; PG8_MMA(1, 0, At, B0); PG8_MMA(1, 1, At, B1); PG8_BAR; PG8_SCHED;
            PG8_LDB(B0, 1, 0); PG8_LDB(B1, 1, 1); PG8_SCHED; PG8_LDA(At, 1, 0); PG8_STAGE(PG8_SA(0, 1), a2 + hstep, voffA);
            PG8_WAIT_V(8); PG8_WAIT_L(0); PG8_BAR; PG8_MMA(0, 0, At, B0); PG8_MMA(0, 1, At, B1); PG8_BAR; PG8_SCHED;
            PG8_LDA(At, 1, 1); PG8_STAGE(PG8_SB(1, 0), b3, voffB); PG8_STAGE(PG8_SB(1, 1), b3 + hstep, voffB); PG8_STAGE(PG8_SA(1, 0), a3, voffA);
            PG8_WAIT_V(8); PG8_WAIT_L(0); PG8_BAR; PG8_MMA(1, 0, At, B0); PG8_MMA(1, 1, At, B1); PG8_BAR; PG8_SCHED;
            } else {
            PG8_LDB(B0, 0, 0); PG8_SCHED; PG8_LDA(At, 0, 0); PG8_STAGE(PG8_SA(1, 1), a1 + hstep, voffA);
            PG8_WAIT_L(8); PG8_BAR; PG8_WAIT_L(0); PG8_MMA(0, 0, At, B0); PG8_BAR; PG8_SCHED;
            PG8_LDB(B1, 0, 1); PG8_STAGE(PG8_SB(0, 0), b2, voffB);
            PG8_BAR; PG8_WAIT_L(0); PG8_MMA(0, 1, At, B1); PG8_BAR;
            PG8_LDA(At, 0, 1); PG8_STAGE(PG8_SA(0, 0), a2, voffA);
            PG8_BAR; PG8_WAIT_L(0); PG8_MMA(1, 0, At, B0); PG8_BAR; PG8_SCHED;
            PG8_STAGE(PG8_SB(0, 1), b2 + hstep, voffB);
            PG8_WAIT_V(6); PG8_BAR; PG8_MMA(1, 1, At, B1); PG8_BAR;
            PG8_LDB(B0, 1, 0); PG8_SCHED; PG8_LDA(At, 1, 0); PG8_STAGE(PG8_SA(0, 1), a2 + hstep, voffA);
            PG8_WAIT_L(8); PG8_BAR; PG8_WAIT_L(0); PG8_MMA(0, 0, At, B0); PG8_BAR; PG8_SCHED;
            PG8_LDB(B1, 1, 1); PG8_STAGE(PG8_SB(1, 0), b3, voffB);
            PG8_BAR; PG8_WAIT_L(0); PG8_MMA(0, 1, At, B1); PG8_BAR;
            PG8_LDA(At, 1, 1); PG8_STAGE(PG8_SA(1, 0), a3, voffA);
            PG8_BAR; PG8_WAIT_L(0); PG8_MMA(1, 0, At, B0); PG8_BAR; PG8_SCHED;
            PG8_STAGE(PG8_SB(1, 1), b3 + hstep, voffB);
            PG8_WAIT_V(6); PG8_BAR; PG8_MMA(1, 1, At, B1); PG8_BAR;
            }
        }
        if constexpr (ALIGN_EPI) { if (wr == 0) PG8_BAR; }
        E(acc, cur, wr, wc, fr, fq); S.done(cur);
        if (!has_next) break;
#pragma unroll
        for (int a = 0; a < 2; ++a)
#pragma unroll
            for (int b = 0; b < 2; ++b)
#pragma unroll
                for (int m = 0; m < 4; ++m)
#pragma unroll
                    for (int n = 0; n < 2; ++n) acc[a][b][m][n] = (f32x4){0.f, 0.f, 0.f, 0.f};
        cur = nxt; cA = nA; cB = nB; ++ui;
        if constexpr (ALIGN_EPI) { if (wr == 1) PG8_BAR; }
    }
    PG8_WAIT_V(0);
    if constexpr (!ALIGN_EPI) { if (wr == 0) PG8_BAR; }
    PG8_BAR;
#undef PG8_SA
#undef PG8_SB
#undef PG8_STAGE
#undef PG8_LDA
#undef PG8_LDB
#undef PG8_MMA
#undef PG8_WAIT_V
#undef PG8_WAIT_L
#undef PG8_BAR
#undef PG8_SCHED
}
}

struct EpiInProj {
    static constexpr bool PERM = true;
    unsigned char* ws; const float* bias; float* out;
    __device__ __forceinline__ void operator()(const f32x4 (&acc)[2][2][4][2], const pg8::Unit& u, int wr, int wc, int fr, int fq) const {
        const int colt = u.pn * 256, t = colt >> 9, cl = colt & 511;
        bf16* base = (bf16*)(ws + WS_QA + (size_t)t * (33 * MiB) + (t >= 2 ? 4 * MiB : 0) + (t >= 3 ? 4 * MiB : 0));
        const float sc = (t == 0) ? QSCALE : ((t == 4) ? KBSCALE : 1.f);
        const int row0 = u.pm * 256 + wr * 64 + fr, col0 = cl + wc * 32 + 8 * fq, bcol0 = colt + wc * 32 + 8 * fq;
        const bool kv = (t == 1 || t == 2);
        const bool ptail = kv && ((u.pm & 63) >= 62) && (u.pm < 128);
        const bool samp = (u.pm >= 128);
        const bool wf32 = kv && (samp || ptail);
        const size_t foff = (samp ? O_KS : O_KP) + ((t == 2) ? (samp ? (O_VS - O_KS) : (O_VP - O_KP)) : (size_t)0);
        float* of32 = out + foff;
        f32x4 bv[2][2];
#pragma unroll
        for (int bj = 0; bj < 2; ++bj)
#pragma unroll
            for (int n = 0; n < 2; ++n) bv[bj][n] = *(const f32x4*)(bias + bcol0 + bj * 128 + 4 * n);
#pragma unroll
        for (int ai = 0; ai < 2; ++ai)
#pragma unroll
            for (int m = 0; m < 4; ++m) {
                const int row = row0 + ai * 128 + m * 16;
                int orow = row;
                if (kv && samp) { const int s = row - MP; orow = MP + (s >> 6) * 576 + 512 + (s & 63); }
                long frow = 0;
                if (wf32) frow = samp ? (long)(row - MP) : (long)((row >> 14) * 512 + ((row & (SEQ - 1)) - (SEQ - 512)));
#pragma unroll
                for (int bj = 0; bj < 2; ++bj) {
                    f32x4 v0 = acc[ai][bj][m][0] + bv[bj][0], v1 = acc[ai][bj][m][1] + bv[bj][1];
                    if (wf32) { float* fp = of32 + frow * 512 + col0 + bj * 128; *(f32x4*)fp = v0; *(f32x4*)(fp + 4) = v1; }
                    if (t == 6) {
#pragma unroll
                        for (int e = 0; e < 4; ++e) { v0[e] = __builtin_amdgcn_rcpf(1.f + __expf(-v0[e])); v1[e] = __builtin_amdgcn_rcpf(1.f + __expf(-v1[e])); }
                    }
                    v0 = v0 * sc; v1 = v1 * sc;
                    v4u w; w.x = cvt_pk_bf16(v0[0], v0[1]); w.y = cvt_pk_bf16(v0[2], v0[3]); w.z = cvt_pk_bf16(v1[0], v1[1]); w.w = cvt_pk_bf16(v1[2], v1[3]);
                    *(v4u*)(base + (size_t)orow * AW + col0 + bj * 128) = w;
                }
            }
    }
};
struct EpiZ1 {
    static constexpr bool PERM = true;
    const float* xp; const float* xs; bf16* z1; float* stat; bool do_stat;
    __device__ __forceinline__ void operator()(const f32x4 (&acc)[2][2][4][2], const pg8::Unit& u, int wr, int wc, int fr, int fq) const {
        const int row0 = u.pm * 256 + wr * 64 + fr, col0 = u.pn * 256 + wc * 32 + 8 * fq;
#pragma unroll
        for (int ai = 0; ai < 2; ++ai)
#pragma unroll
            for (int m = 0; m < 4; ++m) {
                const int row = row0 + ai * 128 + m * 16;
                const float* xr = (row < MP) ? xp + (size_t)row * DM : xs + (size_t)(row - MP) * DM;
                float s = 0.f, q = 0.f;
#pragma unroll
                for (int bj = 0; bj < 2; ++bj) {
                    const f32x4 x0 = *(const f32x4*)(xr + col0 + bj * 128), x1 = *(const f32x4*)(xr + col0 + bj * 128 + 4);
                    const f32x4 v0 = x0 * ALPHA + acc[ai][bj][m][0], v1 = x1 * ALPHA + acc[ai][bj][m][1];
                    s += (v0[0] + v0[1]) + (v0[2] + v0[3]) + (v1[0] + v1[1]) + (v1[2] + v1[3]);
                    q += (v0[0] * v0[0] + v0[1] * v0[1]) + (v0[2] * v0[2] + v0[3] * v0[3]) + (v1[0] * v1[0] + v1[1] * v1[1]) + (v1[2] * v1[2] + v1[3] * v1[3]);
                    v4u w; w.x = cvt_pk_bf16(v0[0], v0[1]); w.y = cvt_pk_bf16(v0[2], v0[3]); w.z = cvt_pk_bf16(v1[0], v1[1]); w.w = cvt_pk_bf16(v1[2], v1[3]);
                    *(v4u*)(z1 + (size_t)row * DM + col0 + bj * 128) = w;
                }
                s += __shfl_xor(s, 16); s += __shfl_xor(s, 32); q += __shfl_xor(q, 16); q += __shfl_xor(q, 32);
                if (fq == 0 && do_stat) { atomicAdd(stat + 2 * row, s); atomicAdd(stat + 2 * row + 1, q); }
            }
    }
};
struct EpiFfn1 {
    static constexpr bool PERM = true;
    const float* stat; const float* c1; const float* c2; bf16* hid;
    __device__ __forceinline__ void operator()(const f32x4 (&acc)[2][2][4][2], const pg8::Unit& u, int wr, int wc, int fr, int fq) const {
        const int row0 = u.pm * 256 + wr * 64 + fr, col0 = u.pn * 256 + wc * 32 + 8 * fq;
        f32x4 k1[2][2], k2[2][2];
#pragma unroll
        for (int bj = 0; bj < 2; ++bj)
#pragma unroll
            for (int n = 0; n < 2; ++n) { k1[bj][n] = *(const f32x4*)(c1 + col0 + bj * 128 + 4 * n); k2[bj][n] = *(const f32x4*)(c2 + col0 + bj * 128 + 4 * n); }
#pragma unroll
        for (int ai = 0; ai < 2; ++ai)
#pragma unroll
            for (int m = 0; m < 4; ++m) {
                const int row = row0 + ai * 128 + m * 16;
                const f32x2 st = *(const f32x2*)(stat + 2 * row);
                const float mean = st.x * (1.f / DM), var = fmaxf(st.y * (1.f / DM) - mean * mean, 0.f), rstd = 1.0f / sqrtf(var + LN_EPS);
#pragma unroll
                for (int bj = 0; bj < 2; ++bj) {
                    f32x4 v0 = (acc[ai][bj][m][0] - k1[bj][0] * mean) * rstd + k2[bj][0], v1 = (acc[ai][bj][m][1] - k1[bj][1] * mean) * rstd + k2[bj][1];
#pragma unroll
                    for (int e = 0; e < 4; ++e) { const float a = fmaxf(v0[e], 0.f), b = fmaxf(v1[e], 0.f); v0[e] = a * a; v1[e] = b * b; }
                    v4u w; w.x = cvt_pk_bf16(v0[0], v0[1]); w.y = cvt_pk_bf16(v0[2], v0[3]); w.z = cvt_pk_bf16(v1[0], v1[1]); w.w = cvt_pk_bf16(v1[2], v1[3]);
                    *(v4u*)(hid + (size_t)row * FF + col0 + bj * 128) = w;
                }
            }
    }
};
struct EpiFfn2 {
    static constexpr bool PERM = true;
    const float* stat; const bf16* z1; const float* g1; const float* b1; const float* bias; float* out;
    __device__ __forceinline__ void operator()(const f32x4 (&acc)[2][2][4][2], const pg8::Unit& u, int wr, int wc, int fr, int fq) const {
        const int row0 = u.pm * 256 + wr * 64 + fr, col0 = u.pn * 256 + wc * 32 + 8 * fq;
        f32x4 gg[2][2], bb[2][2], bo[2][2];
#pragma unroll
        for (int bj = 0; bj < 2; ++bj)
#pragma unroll
            for (int n = 0; n < 2; ++n) { gg[bj][n] = *(const f32x4*)(g1 + col0 + bj * 128 + 4 * n); bb[bj][n] = *(const f32x4*)(b1 + col0 + bj * 128 + 4 * n); bo[bj][n] = *(const f32x4*)(bias + col0 + bj * 128 + 4 * n); }
#pragma unroll
        for (int ai = 0; ai < 2; ++ai)
#pragma unroll
            for (int m = 0; m < 4; ++m) {
                const int row = row0 + ai * 128 + m * 16;
                const f32x2 st = *(const f32x2*)(stat + 2 * row);
                const float mean = st.x * (1.f / DM), var = fmaxf(st.y * (1.f / DM) - mean * mean, 0.f), rstd = 1.0f / sqrtf(var + LN_EPS);
#pragma unroll
                for (int bj = 0; bj < 2; ++bj) {
                    const v4u zz = *(const v4u*)(z1 + (size_t)row * DM + col0 + bj * 128);
                    const f32x4 z0 = (f32x4){bflo(zz.x), bfhi(zz.x), bflo(zz.y), bfhi(zz.y)}, z1v = (f32x4){bflo(zz.z), bfhi(zz.z), bflo(zz.w), bfhi(zz.w)};
                    const f32x4 h0 = (z0 - mean) * rstd * gg[bj][0] + bb[bj][0], h1 = (z1v - mean) * rstd * gg[bj][1] + bb[bj][1];
                    const f32x4 o0 = h0 * ALPHA + acc[ai][bj][m][0] + bo[bj][0], o1 = h1 * ALPHA + acc[ai][bj][m][1] + bo[bj][1];
                    float* op = out + (size_t)row * DM + col0 + bj * 128;
                    *(f32x4*)op = o0; *(f32x4*)(op + 4) = o1;
                }
            }
    }
};

struct Args { const float* in[20]; float* out; unsigned char* ws; int ph_lo, ph_hi, coop, pad; };
struct Frame {
    LAS unsigned char* lds;
    int tid, lane, wave, vcu, G;
    float* out; unsigned char* ws;
};

template <class Epi>
__device__ __forceinline__ void small_gemm_phase(Frame& F, const bf16* A, const bf16* Bt, int N, int K, const Epi& E) {
    const int tid = F.tid, lane = F.lane, wid = F.wave, r32 = lane & 31, hi = lane >> 5;
    const int ntn = N / 64, total = 8 * ntn, ks = K / 8;
    LAS float* red = (LAS float*)F.lds;
    for (int tile = F.vcu; tile < total; tile += F.G) {
        const int tm = tile & 7, tn = tile >> 3;
        const bf16* ap = A + (size_t)(64 * tm + r32) * K + wid * ks + 8 * hi;
        const bf16* bp = Bt + (size_t)(64 * tn + r32) * K + wid * ks + 8 * hi;
        f32x16 acc[2][2];
#pragma unroll
        for (int i = 0; i < 2; ++i)
#pragma unroll
            for (int j = 0; j < 2; ++j)
#pragma unroll
                for (int r = 0; r < 16; ++r) acc[i][j][r] = 0.f;
#pragma unroll 4
        for (int k0 = 0; k0 < ks; k0 += 16) {
            const bf16x8 a0 = *(const bf16x8*)(ap + k0), a1 = *(const bf16x8*)(ap + (size_t)32 * K + k0);
            const bf16x8 b0 = *(const bf16x8*)(bp + k0), b1 = *(const bf16x8*)(bp + (size_t)32 * K + k0);
            acc[0][0] = __builtin_amdgcn_mfma_f32_32x32x16_bf16(a0, b0, acc[0][0], 0, 0, 0);
            acc[0][1] = __builtin_amdgcn_mfma_f32_32x32x16_bf16(a0, b1, acc[0][1], 0, 0, 0);
            acc[1][0] = __builtin_amdgcn_mfma_f32_32x32x16_bf16(a1, b0, acc[1][0], 0, 0, 0);
            acc[1][1] = __builtin_amdgcn_mfma_f32_32x32x16_bf16(a1, b1, acc[1][1], 0, 0, 0);
        }
#pragma unroll
        for (int i = 0; i < 2; ++i)
#pragma unroll
            for (int j = 0; j < 2; ++j)
#pragma unroll
                for (int r = 0; r < 16; ++r) red[wid * 4096 + (32 * i + crow(r, hi)) * 64 + 32 * j + r32] = acc[i][j][r];
        __syncthreads();
        {
            const int row = tid >> 3, cg = tid & 7;
            f32x4 v0 = (f32x4){0.f, 0.f, 0.f, 0.f}, v1 = v0;
#pragma unroll
            for (int w = 0; w < 8; ++w) { v0 += *(const LAS f32x4*)(red + w * 4096 + row * 64 + 8 * cg); v1 += *(const LAS f32x4*)(red + w * 4096 + row * 64 + 8 * cg + 4); }
            E(MP + 64 * tm + row, 64 * tn + 8 * cg, v0, v1, cg);
        }
        __syncthreads();
    }
}
struct SEpiInProj {
    unsigned char* ws; const float* bias; float* out;
    __device__ __forceinline__ void operator()(int row, int col, f32x4 v0, f32x4 v1, int) const {
        const int t = col >> 9, cl = col & 511;
        bf16* base = (bf16*)(ws + WS_QA + (size_t)t * (33 * MiB) + (t >= 2 ? 4 * MiB : 0) + (t >= 3 ? 4 * MiB : 0));
        const float sc = (t == 0) ? QSCALE : ((t == 4) ? KBSCALE : 1.f);
        v0 += *(const f32x4*)(bias + col); v1 += *(const f32x4*)(bias + col + 4);
        int orow = row;
        if (t == 1 || t == 2) { const int s = row - MP; orow = MP + (s >> 6) * 576 + 512 + (s & 63);
            float* fp = out + (t == 1 ? O_KS : O_VS) + (size_t)s * 512 + cl; *(f32x4*)fp = v0; *(f32x4*)(fp + 4) = v1; }
        if (t == 6) {
#pragma unroll
            for (int e = 0; e < 4; ++e) { v0[e] = __builtin_amdgcn_rcpf(1.f + __expf(-v0[e])); v1[e] = __builtin_amdgcn_rcpf(1.f + __expf(-v1[e])); }
        }
        v0 = v0 * sc; v1 = v1 * sc;
        v4u w; w.x = cvt_pk_bf16(v0[0], v0[1]); w.y = cvt_pk_bf16(v0[2], v0[3]); w.z = cvt_pk_bf16(v1[0], v1[1]); w.w = cvt_pk_bf16(v1[2], v1[3]);
        *(v4u*)(base + (size_t)orow * AW + cl) = w;
    }
};
struct SEpiZ1 {
    const float* xs; bf16* z1; float* stat;
    __device__ __forceinline__ void operator()(int row, int col, f32x4 a0, f32x4 a1, int cg) const {
        const float* xr = xs + (size_t)(row - MP) * DM + col;
        const f32x4 v0 = *(const f32x4*)xr * ALPHA + a0, v1 = *(const f32x4*)(xr + 4) * ALPHA + a1;
        float s = (v0[0] + v0[1]) + (v0[2] + v0[3]) + (v1[0] + v1[1]) + (v1[2] + v1[3]);
        float q = (v0[0] * v0[0] + v0[1] * v0[1]) + (v0[2] * v0[2] + v0[3] * v0[3]) + (v1[0] * v1[0] + v1[1] * v1[1]) + (v1[2] * v1[2] + v1[3] * v1[3]);
        v4u w; w.x = cvt_pk_bf16(v0[0], v0[1]); w.y = cvt_pk_bf16(v0[2], v0[3]); w.z = cvt_pk_bf16(v1[0], v1[1]); w.w = cvt_pk_bf16(v1[2], v1[3]);
        *(v4u*)(z1 + (size_t)row * DM + col) = w;
        s += __shfl_xor(s, 1); s += __shfl_xor(s, 2); s += __shfl_xor(s, 4); q += __shfl_xor(q, 1); q += __shfl_xor(q, 2); q += __shfl_xor(q, 4);
        if (cg == 0) { atomicAdd(stat + 2 * row, s); atomicAdd(stat + 2 * row + 1, q); }
    }
};
struct SEpiFfn1 {
    const float* stat; const float* c1; const float* c2; bf16* hid;
    __device__ __forceinline__ void operator()(int row, int col, f32x4 a0, f32x4 a1, int) const {
        const f32x2 st = *(const f32x2*)(stat + 2 * row);
        const float mean = st.x * (1.f / DM), var = fmaxf(st.y * (1.f / DM) - mean * mean, 0.f), rstd = 1.0f / sqrtf(var + LN_EPS);
        f32x4 v0 = (a0 - *(const f32x4*)(c1 + col) * mean) * rstd + *(const f32x4*)(c2 + col), v1 = (a1 - *(const f32x4*)(c1 + col + 4) * mean) * rstd + *(const f32x4*)(c2 + col + 4);
#pragma unroll
        for (int e = 0; e < 4; ++e) { const float a = fmaxf(v0[e], 0.f), b = fmaxf(v1[e], 0.f); v0[e] = a * a; v1[e] = b * b; }
        v4u w; w.x = cvt_pk_bf16(v0[0], v0[1]); w.y = cvt_pk_bf16(v0[2], v0[3]); w.z = cvt_pk_bf16(v1[0], v1[1]); w.w = cvt_pk_bf16(v1[2], v1[3]);
        *(v4u*)(hid + (size_t)row * FF + col) = w;
    }
};
struct SEpiFfn2 {
    const float* stat; const bf16* z1; const float* g1; const float* b1; const float* bias; float* out;
    __device__ __forceinline__ void operator()(int row, int col, f32x4 a0, f32x4 a1, int) const {
        const f32x2 st = *(const f32x2*)(stat + 2 * row);
        const float mean = st.x * (1.f / DM), var = fmaxf(st.y * (1.f / DM) - mean * mean, 0.f), rstd = 1.0f / sqrtf(var + LN_EPS);
        const v4u zz = *(const v4u*)(z1 + (size_t)row * DM + col);
        const f32x4 z0 = (f32x4){bflo(zz.x), bfhi(zz.x), bflo(zz.y), bfhi(zz.y)}, z1v = (f32x4){bflo(zz.z), bfhi(zz.z), bflo(zz.w), bfhi(zz.w)};
        const f32x4 h0 = (z0 - mean) * rstd * *(const f32x4*)(g1 + col) + *(const f32x4*)(b1 + col), h1 = (z1v - mean) * rstd * *(const f32x4*)(g1 + col + 4) + *(const f32x4*)(b1 + col + 4);
        float* op = out + (size_t)row * DM + col;
        *(f32x4*)op = h0 * ALPHA + a0 + *(const f32x4*)(bias + col); *(f32x4*)(op + 4) = h1 * ALPHA + a1 + *(const f32x4*)(bias + col + 4);
    }
};


template <bool FOLD>
__device__ __forceinline__ void p0_transpose_item(const float* W, int K, int N, int ldw, bf16* WT, LAS float* scr, int item, int lane,
                                                  const float* g, const float* b, float* c1p, float* c2p) {
    const int nblk = N / 32, kb = item / nblk, nb = item % nblk, k0 = 64 * kb, n0 = 32 * nb;
#pragma unroll 8
    for (int i = 0; i < 32; ++i) { const int kk = 2 * i + (lane >> 5); scr[kk * 33 + (lane & 31)] = W[(size_t)(k0 + kk) * ldw + n0 + (lane & 31)]; }
    LDS_WAIT(); asm volatile("" ::: "memory");
    if constexpr (FOLD) {
        const int n = lane & 31, hf = lane >> 5; float s1 = 0.f, s2 = 0.f;
#pragma unroll 8
        for (int i = 0; i < 32; ++i) { const int kk = hf * 32 + i; const float w = scr[kk * 33 + n]; const float gw = w * g[k0 + kk];
            const float gr = __builtin_bit_cast(float, f2bf(gw) << 16); s1 += gr; s2 += w * b[k0 + kk]; scr[kk * 33 + n] = gw; }
        s1 += __shfl_xor(s1, 32); s2 += __shfl_xor(s2, 32);
        if (lane < 32) { c1p[(size_t)kb * N + n0 + n] = s1; c2p[(size_t)kb * N + n0 + n] = s2; }
        LDS_WAIT(); asm volatile("" ::: "memory");
    }
    const int c = lane & 7;
#pragma unroll
    for (int j = 0; j < 4; ++j) { const int n = (lane >> 3) + 8 * j; const LAS float* s = scr + (8 * c) * 33 + n;
        v4u o; o.x = pk2(s[0 * 33], s[1 * 33]); o.y = pk2(s[2 * 33], s[3 * 33]); o.z = pk2(s[4 * 33], s[5 * 33]); o.w = pk2(s[6 * 33], s[7 * 33]);
        *(GAS v4u*)(WT + (size_t)(n0 + n) * K + k0 + 8 * c) = o; }
    LDS_WAIT(); asm volatile("" ::: "memory");
}

__device__ __forceinline__ void p0_prologue(Frame& F, const Args& A) {
    const float* xp = A.in[0]; const float* xs = A.in[1]; const float* ck = A.in[2]; const float* cv = A.in[3];
    const float* w_in = A.in[7]; const float* b_in = A.in[8]; const float* w_out = A.in[11]; const float* ln1g = A.in[12]; const float* ln1b = A.in[13];
    const float* w1 = A.in[14]; const float* w2 = A.in[16];
    bf16* WIN = (bf16*)(F.ws + WS_WIN); bf16* WOUT = (bf16*)(F.ws + WS_WOUT); bf16* W1T = (bf16*)(F.ws + WS_W1); bf16* W2T = (bf16*)(F.ws + WS_W2);
    bf16* XB = (bf16*)(F.ws + WS_XB); bf16* KA = (bf16*)(F.ws + WS_KA); bf16* VA = (bf16*)(F.ws + WS_VA);
    float* IG = (float*)(F.ws + WS_IG); float* LFp = (float*)(F.ws + WS_LF); float* STAT = (float*)(F.ws + WS_STAT1);
    float* C1P = (float*)(F.ws + WS_C1P); float* C2P = (float*)(F.ws + WS_C2P);
    LAS float* scr = (LAS float*)(F.lds + F.wave * 8704);
    LAS float* wg = (LAS float*)(F.lds + 98304);
    const int gw = F.vcu * 8 + F.wave, NGW = F.G * 8;
    for (int k = F.tid; k < DM; k += 512) { const f32x4 a = *(const f32x4*)(w_in + (size_t)k * INW + NIN), b = *(const f32x4*)(w_in + (size_t)k * INW + NIN + 4);
        wg[0 * DM + k] = a[0]; wg[1 * DM + k] = a[1]; wg[2 * DM + k] = a[2]; wg[3 * DM + k] = a[3]; wg[4 * DM + k] = b[0]; wg[5 * DM + k] = b[1]; wg[6 * DM + k] = b[2]; wg[7 * DM + k] = b[3]; }
    for (int i = (int)blockIdx.x * 512 + F.tid; i < MT * 2; i += F.G * 512) STAT[i] = 0.f;
    __syncthreads();
    constexpr int I_IN = (DM / 64) * (NIN / 32), I_OUT = (DM / 64) * (DM / 32), I_1 = (DM / 64) * (FF / 32), I_2 = (FF / 64) * (DM / 32);
    constexpr int NITEMS = I_IN + I_OUT + I_1 + I_2;
    for (int it = gw; it < NITEMS; it += NGW) {
        int r = it;
        if (r < I_IN) { p0_transpose_item<false>(w_in, DM, NIN, INW, WIN, scr, r, F.lane, nullptr, nullptr, nullptr, nullptr); continue; } r -= I_IN;
        if (r < I_OUT) { p0_transpose_item<false>(w_out, DM, DM, DM, WOUT, scr, r, F.lane, nullptr, nullptr, nullptr, nullptr); continue; } r -= I_OUT;
        if (r < I_1) { p0_transpose_item<true>(w1, DM, FF, FF, W1T, scr, r, F.lane, ln1g, ln1b, C1P, C2P); continue; } r -= I_1;
        p0_transpose_item<false>(w2, FF, DM, DM, W2T, scr, r, F.lane, nullptr, nullptr, nullptr, nullptr);
    }
    for (int m = gw; m < MT; m += NGW) {
        const float* xrow = (m < MP) ? xp + (size_t)m * DM : xs + (size_t)(m - MP) * DM;
        const GAS f32x4* xr = (const GAS f32x4*)xrow + F.lane;
        f32x4 v[4]; float a[8];
#pragma unroll
        for (int g = 0; g < 8; ++g) a[g] = 0.f;
#pragma unroll
        for (int j = 0; j < 4; ++j) v[j] = xr[64 * j];
#pragma unroll
        for (int j = 0; j < 4; ++j)
#pragma unroll
            for (int g = 0; g < 8; ++g) { const f32x4 w = *(const LAS f32x4*)(wg + g * DM + 256 * j + 4 * F.lane); a[g] += (v[j][0] * w[0] + v[j][1] * w[1]) + (v[j][2] * w[2] + v[j][3] * w[3]); }
        GAS unsigned long long* o8 = (GAS unsigned long long*)(XB + (size_t)m * DM) + F.lane;
#pragma unroll
        for (int j = 0; j < 4; ++j) o8[64 * j] = (unsigned long long)pk2(v[j][0], v[j][1]) | ((unsigned long long)pk2(v[j][2], v[j][3]) << 32);
#pragma unroll
        for (int g = 0; g < 8; ++g) a[g] = wave_sum(a[g]);
        if (F.lane < 8) {
            float val = a[0];
#pragma unroll
            for (int g = 1; g < 8; ++g) val = (F.lane == g) ? a[g] : val;
            val += b_in[NIN + F.lane];
            if (F.lane < 4) IG[(size_t)m * 4 + F.lane] = val;
            else { const float ls = fminf(val, 0.f) - log1pf(__expf(-fabsf(val))); LFp[(size_t)m * 4 + F.lane - 4] = ls; }
        }
    }
    for (int it = gw; it < 2 * DB * 512; it += NGW) {
        const int which = it >= DB * 512, r = which ? it - DB * 512 : it, db = r >> 9, rr = r & 511;
        const float* src = (which ? cv : ck) + (size_t)r * AW + 8 * F.lane;
        const f32x4 a = *(const f32x4*)src, b = *(const f32x4*)(src + 4);
        v4u o; o.x = pk2(a[0], a[1]); o.y = pk2(a[2], a[3]); o.z = pk2(b[0], b[1]); o.w = pk2(b[2], b[3]);
        *(v4u*)((which ? VA : KA) + (size_t)(MP + db * 576 + rr) * AW + 8 * F.lane) = o;
    }
}

constexpr int AT_NS = 3, AT_K = 0, AT_V = AT_NS * 8192, AT_BIAS = 2 * AT_NS * 8192, AT_BT = 260, AT_WS = AT_BIAS + 4 * AT_BT * 4 + 64, AT_OST = AT_WS + 2048;
constexpr float AT_THR = 8.0f;
__device__ __forceinline__ void glds16(const void* gsrc, unsigned lds_dst) { unsigned keep;
    asm volatile("s_mov_b32 %0, m0\n\ts_mov_b32 m0, %2\n\ts_nop 0\n\tglobal_load_lds_dwordx4 %1, off\n\ts_mov_b32 m0, %0" : "=&s"(keep) : "v"(gsrc), "s"(lds_dst) : "memory"); }
#define AT_WAIT_BAR(N) asm volatile("s_waitcnt vmcnt(" #N ") lgkmcnt(0)\n\ts_barrier" ::: "memory")
#define MX3(a, b, c) __builtin_fmaxf(__builtin_fmaxf((a), (b)), (c))
__device__ __forceinline__ void attn_unit(Frame& F, const bf16* Q, const bf16* K, const bf16* V, bf16* MIX, const float* relb,
                                          int h, long qrow_base, long kv_base, int i_lo, int i_hi, int nactive, bool fill_bias) {
    const int tid = F.tid, lane = F.lane, r32 = lane & 31, hi = lane >> 5, wid = F.wave;
    const int wq = wid >> 1, wh = wid & 1;
    const bool active = wid < nactive;
    LAS unsigned char* lds = F.lds;
    LAS float* btab = (LAS float*)(lds + AT_BIAS);
    LAS float* wsf = (LAS float*)(lds + AT_WS) + wid * 64;
    const unsigned lds0 = (unsigned)(uintptr_t)lds;
    const int n = i_hi - i_lo + 1;
    const bf16* ksrc = K + (kv_base + 64 * (long)i_lo + lane) * AW + h * 64 + wid * 8;
    const bf16* vsrc = V + (kv_base + 64 * (long)i_lo + 16 * (wid & 3) + (lane >> 2)) * AW + h * 64 + (wid >> 2) * 32 + (lane & 3) * 8;
    const unsigned kdst = lds0 + AT_K + wid * 1024, vdst = lds0 + AT_V + wid * 1024;
#define AT_STAGE(t_, slot_) do { glds16(ksrc + (long)(t_) * 64 * AW, (unsigned)__builtin_amdgcn_readfirstlane(kdst + (slot_) * 8192)); \
                                 glds16(vsrc + (long)(t_) * 64 * AW, (unsigned)__builtin_amdgcn_readfirstlane(vdst + (slot_) * 8192)); } while (0)
    AT_STAGE(0, 0);
    if (n > 1) AT_STAGE(1, 1);
    if (fill_bias) {
        const float cf = relb[h * 257 + 256]; float bvv[3];
#pragma unroll
        for (int k = 0; k < 3; ++k) { const int e = tid + 512 * k, sft = e / AT_BT, j = e - sft * AT_BT; int i = 320 - j - sft; i = i > 256 ? 256 : i; i = i < 0 ? 0 : i; bvv[k] = relb[h * 257 + i]; }
#pragma unroll
        for (int k = 0; k < 3; ++k) { const int e = tid + 512 * k; if (e < 4 * AT_BT) btab[e] = (bvv[k] - cf) * LOG2E; }
    }
    const long qrow = qrow_base + 64 * wq + 32 * wh;
    bf16x8 qr[4];
#pragma unroll
    for (int d0 = 0; d0 < 4; ++d0) qr[d0] = (bf16x8){0, 0, 0, 0, 0, 0, 0, 0};
    if (active) {
#pragma unroll
        for (int d0 = 0; d0 < 4; ++d0) qr[d0] = *(const bf16x8*)(Q + (qrow + r32) * AW + h * 64 + d0 * 16 + hi * 8);
    }
    asm volatile("" :: "v"(qr[0]), "v"(qr[1]), "v"(qr[2]), "v"(qr[3]));
    float m_run = 0.f;
    f32x16 o[2], lacc, negm;
#pragma unroll
    for (int r = 0; r < 16; ++r) { o[0][r] = 0.f; o[1][r] = 0.f; lacc[r] = 0.f; negm[r] = 0.f; }
    const bf16x8 ones = (bf16x8){0x3F80, 0x3F80, 0x3F80, 0x3F80, 0x3F80, 0x3F80, 0x3F80, 0x3F80};
    const int qi = 32 * wh + r32, bsft = (-qi) & 3;
    const LAS float* bt = btab + bsft * AT_BT - bsft;
    int slot = 0, slot2 = 2;
    for (int t = 0; t < n; ++t) {
        if (t + 1 < n) { AT_WAIT_BAR(2); } else { AT_WAIT_BAR(0); }
        if (t + 2 < n) AT_STAGE(t + 2, slot2);
        const int i = i_lo + t;
        if (active && i >= wq && i <= wq + 8) {
            const int delta = wq + 8 - i;
            const LAS unsigned char* kb = lds + AT_K + slot * 8192 + hi * 1024 + r32 * 16;
            f32x16 p0, p1;
            {
                const bf16x8 b0 = *(const LAS bf16x8*)(kb), b1 = *(const LAS bf16x8*)(kb + 512);
                p0 = __builtin_amdgcn_mfma_f32_32x32x16_bf16(b0, qr[0], negm, 0, 0, 0);
                p1 = __builtin_amdgcn_mfma_f32_32x32x16_bf16(b1, qr[0], negm, 0, 0, 0);
            }
#pragma unroll
            for (int d0 = 1; d0 < 4; ++d0) {
                const bf16x8 b0 = *(const LAS bf16x8*)(kb + d0 * 2048), b1 = *(const LAS bf16x8*)(kb + d0 * 2048 + 512);
                p0 = __builtin_amdgcn_mfma_f32_32x32x16_bf16(b0, qr[d0], p0, 0, 0, 0);
                p1 = __builtin_amdgcn_mfma_f32_32x32x16_bf16(b1, qr[d0], p1, 0, 0, 0);
            }
            if (delta <= 2) {
                const LAS float* bp = bt + (192 - 64 * delta - qi + 4 * hi);
#pragma unroll
                for (int g4 = 0; g4 < 4; ++g4) { const f32x4 b0v = *(const LAS f32x4*)(bp + 8 * g4), b1v = *(const LAS f32x4*)(bp + 8 * g4 + 32);
#pragma unroll
                    for (int e = 0; e < 4; ++e) { p0[4 * g4 + e] += b0v[e]; p1[4 * g4 + e] += b1v[e]; } }
            }
            float ra = MX3(p0[0], p0[1], p1[0]), rb = MX3(p0[2], p0[3], p1[1]); ra = MX3(ra, p1[2], p1[3]);
#pragma unroll
            for (int r = 4; r < 16; r += 4) { ra = MX3(ra, p0[r], p0[r + 1]); rb = MX3(rb, p0[r + 2], p0[r + 3]); ra = MX3(ra, p1[r], p1[r + 1]); rb = MX3(rb, p1[r + 2], p1[r + 3]); }
            const float rm = swap_max(fmaxf(ra, rb));
            if (__builtin_expect(__any(fabsf(rm) > AT_THR), 0)) {
                const float dl = rm, f = __builtin_amdgcn_exp2f(-dl);
                m_run += dl;
#pragma unroll
                for (int r = 0; r < 16; ++r) { p0[r] -= dl; p1[r] -= dl; negm[r] = -m_run; }
                if (hi == 0) wsf[r32] = f;
                LDS_WAIT();
#pragma unroll
                for (int r = 0; r < 16; ++r) { const float fr_ = wsf[crow(r, hi)]; o[0][r] *= fr_; o[1][r] *= fr_; lacc[r] *= fr_; }
                LDS_WAIT();
            }
#pragma unroll
            for (int r = 0; r < 16; ++r) { p0[r] = __builtin_amdgcn_exp2f(p0[r]); p1[r] = __builtin_amdgcn_exp2f(p1[r]); }
            v4u pw[4];
            pw[0] = (v4u){cvt_pk_bf16(p0[0], p0[1]), cvt_pk_bf16(p0[2], p0[3]), cvt_pk_bf16(p0[4], p0[5]), cvt_pk_bf16(p0[6], p0[7])};
            pw[1] = (v4u){cvt_pk_bf16(p0[8], p0[9]), cvt_pk_bf16(p0[10], p0[11]), cvt_pk_bf16(p0[12], p0[13]), cvt_pk_bf16(p0[14], p0[15])};
            pw[2] = (v4u){cvt_pk_bf16(p1[0], p1[1]), cvt_pk_bf16(p1[2], p1[3]), cvt_pk_bf16(p1[4], p1[5]), cvt_pk_bf16(p1[6], p1[7])};
            pw[3] = (v4u){cvt_pk_bf16(p1[8], p1[9]), cvt_pk_bf16(p1[10], p1[11]), cvt_pk_bf16(p1[12], p1[13]), cvt_pk_bf16(p1[14], p1[15])};
            const LAS unsigned char* vb = lds + AT_V + slot * 8192 + ((lane >> 4) & 1) * 32 + (lane & 3) * 8 + (4 * hi + ((lane & 15) >> 2)) * 64;
#pragma unroll
            for (int ks = 0; ks < 4; ++ks) {
                const bf16x8 pa = __builtin_bit_cast(bf16x8, pw[ks]);
                const bf16x8 v0 = trfrag(vb + ks * 1024), v1 = trfrag(vb + 4096 + ks * 1024);
                o[0] = __builtin_amdgcn_mfma_f32_32x32x16_bf16(pa, v0, o[0], 0, 0, 0);
                o[1] = __builtin_amdgcn_mfma_f32_32x32x16_bf16(pa, v1, o[1], 0, 0, 0);
                lacc = __builtin_amdgcn_mfma_f32_32x32x16_bf16(pa, ones, lacc, 0, 0, 0);
            }
        }
        slot = (slot == AT_NS - 1) ? 0 : slot + 1; slot2 = (slot2 == AT_NS - 1) ? 0 : slot2 + 1;
    }
    if (active) {
        LAS bf16* stg = (LAS bf16*)(lds + AT_OST) + wid * 2048;
#pragma unroll
        for (int r = 0; r < 16; ++r) { const int orow = crow(r, hi); const float rl = __builtin_amdgcn_rcpf(lacc[r]);
            stg[orow * 64 + r32] = (bf16)f2bf(o[0][r] * rl); stg[orow * 64 + 32 + r32] = (bf16)f2bf(o[1][r] * rl); }
        LDS_WAIT();
#pragma unroll
        for (int i = 0; i < 4; ++i) { const int row = i * 8 + (lane >> 3), ch = lane & 7; const v4u v = *(const LAS v4u*)(stg + row * 64 + ch * 8);
            *(v4u*)(MIX + (qrow + row) * DM + h * 64 + ch * 8) = v; }
    }
    AT_WAIT_BAR(0);
#undef AT_STAGE
}

__device__ __forceinline__ int tr_off(int s, int c16) { return (c16 >> 2) * 4096 + (s >> 4) * 1024 + (s & 15) * 64 + (c16 & 3) * 16; }
__device__ __forceinline__ int tr_read_base(int lane) { const int hi = lane >> 5; return ((lane >> 4) & 1) * 32 + (lane & 3) * 8 + (4 * hi + ((lane & 15) >> 2)) * 64; }
__device__ __forceinline__ v4u scale8(v4u k, float w) {
    v4u o; o.x = pk2(bflo(k.x) * w, bfhi(k.x) * w); o.y = pk2(bflo(k.y) * w, bfhi(k.y) * w); o.z = pk2(bflo(k.z) * w, bfhi(k.z) * w); o.w = pk2(bflo(k.w) * w, bfhi(k.w) * w); return o;
}

__device__ __forceinline__ void mlstm_stage1_item(Frame& F, int item) {
    const int tid = F.tid, lane = F.lane, wid = F.wave, r32 = lane & 31, hi = lane >> 5;
    const int seq = item >> 5, j = item & 31, b = seq >> 2, h = seq & 3;
    const long row0 = (long)b * SEQ + (long)j * 512;
    const bf16* KB = (const bf16*)(F.ws + WS_KB); const bf16* VB = (const bf16*)(F.ws + WS_VB);
    const float* IG = (const float*)(F.ws + WS_IG); const float* LFp = (const float*)(F.ws + WS_LF);
    LAS unsigned char* lds = F.lds;
    LAS float* wts = (LAS float*)(lds + 32768); LAS float* red = (LAS float*)(lds + 34816);
    v4u kv[2], vv[2];
    const int prow = tid >> 4, pc16 = tid & 15;
    const size_t poff = (size_t)(row0 + prow) * AW + h * 128 + pc16 * 8;
#pragma unroll
    for (int i = 0; i < 2; ++i) { kv[i] = *(const v4u*)(KB + poff + (size_t)i * 32 * AW); vv[i] = *(const v4u*)(VB + poff + (size_t)i * 32 * AW); }
    const float lfv = LFp[(row0 + tid) * 4 + h], igv = IG[(row0 + tid) * 4 + h];
    float bs = lfv;
#pragma unroll
    for (int off = 1; off < 64; off <<= 1) { const float t = __shfl_up(bs, off); if (lane >= off) bs += t; }
    if (lane == 63) red[wid] = bs;
    __syncthreads();
    float woff = 0.f, btot = 0.f;
#pragma unroll
    for (int w = 0; w < 8; ++w) { const float t = red[w]; if (w < wid) woff += t; btot += t; }
    bs += woff;
    const float e = btot - bs + igv;
    float mx = e;
#pragma unroll
    for (int o = 1; o < 64; o <<= 1) mx = fmaxf(mx, __shfl_xor(mx, o));
    if (lane == 0) red[16 + wid] = mx;
    __syncthreads();
    float mloc = red[16];
#pragma unroll
    for (int w = 1; w < 8; ++w) mloc = fmaxf(mloc, red[16 + w]);
    wts[tid] = __expf(e - mloc);
    __syncthreads();
    f32x16 acc[2], nacc;
#pragma unroll
    for (int r = 0; r < 16; ++r) { acc[0][r] = 0.f; acc[1][r] = 0.f; nacc[r] = 0.f; }
    const bf16x8 ones = (bf16x8){0x3F80, 0x3F80, 0x3F80, 0x3F80, 0x3F80, 0x3F80, 0x3F80, 0x3F80};
    const int kb = wid >> 1, vb0 = 2 * (wid & 1);
    const int trb = tr_read_base(lane);
    for (int c = 0; c < 8; ++c) {
#pragma unroll
        for (int i = 0; i < 2; ++i) { const int row = prow + 32 * i;
            *(LAS v4u*)(lds + tr_off(row, pc16)) = scale8(kv[i], wts[c * 64 + row]); *(LAS v4u*)(lds + 16384 + tr_off(row, pc16)) = vv[i]; }
        if (c + 1 < 8) {
#pragma unroll
            for (int i = 0; i < 2; ++i) { kv[i] = *(const v4u*)(KB + poff + (size_t)((c + 1) * 64 + i * 32) * AW); vv[i] = *(const v4u*)(VB + poff + (size_t)((c + 1) * 64 + i * 32) * AW); }
        }
        __syncthreads();
#pragma unroll
        for (int ks = 0; ks < 4; ++ks) {
            const bf16x8 af = trfrag(lds + kb * 4096 + ks * 1024 + trb);
#pragma unroll
            for (int vi = 0; vi < 2; ++vi) { const bf16x8 bfr = trfrag(lds + 16384 + (vb0 + vi) * 4096 + ks * 1024 + trb);
                acc[vi] = __builtin_amdgcn_mfma_f32_32x32x16_bf16(af, bfr, acc[vi], 0, 0, 0); }
            nacc = __builtin_amdgcn_mfma_f32_32x32x16_bf16(af, ones, nacc, 0, 0, 0);
        }
        __syncthreads();
    }
    float* U = (float*)(F.ws + WS_SCU) + (size_t)item * 16384;
#pragma unroll
    for (int vi = 0; vi < 2; ++vi) { const int v = 32 * (vb0 + vi) + r32;
#pragma unroll
        for (int g4 = 0; g4 < 4; ++g4) *(f32x4*)(U + v * 128 + 32 * kb + 8 * g4 + 4 * hi) = (f32x4){acc[vi][4 * g4], acc[vi][4 * g4 + 1], acc[vi][4 * g4 + 2], acc[vi][4 * g4 + 3]}; }
    if ((wid & 1) == 0 && r32 == 0) { float* nu = (float*)(F.ws + WS_SCNU) + item * 128 + 32 * kb + 4 * hi;
#pragma unroll
        for (int g4 = 0; g4 < 4; ++g4) *(f32x4*)(nu + 8 * g4) = (f32x4){nacc[4 * g4], nacc[4 * g4 + 1], nacc[4 * g4 + 2], nacc[4 * g4 + 3]}; }
    if (tid == 0) { ((float*)(F.ws + WS_SCML))[item] = mloc; ((float*)(F.ws + WS_SCBS))[item] = btot; }
    __syncthreads();
}

__device__ __forceinline__ void p3_scan(Frame& F, const float* bff1) {
    const int gid = F.vcu * 512 + F.tid, NT = F.G * 512;
    const float* U = (const float*)(F.ws + WS_SCU); const float* NU = (const float*)(F.ws + WS_SCNU);
    const float* ML = (const float*)(F.ws + WS_SCML); const float* BS = (const float*)(F.ws + WS_SCBS);
    float* STC = (float*)(F.ws + WS_STC); float* STN = (float*)(F.ws + WS_STN); float* STM = (float*)(F.ws + WS_STM);
    for (int e = gid; e < 8 * 16384; e += NT) {
        const int seq = e >> 14, el = e & 16383;
        const float* up = U + (size_t)(seq * 32) * 16384 + el; float* sp = STC + (size_t)(seq * 32) * 16384 + el;
        float u[31];
#pragma unroll
        for (int j = 0; j < 31; ++j) u[j] = up[(size_t)j * 16384];
        float c = 0.f, m = 0.f;
#pragma unroll
        for (int j = 0; j < 32; ++j) {
            sp[(size_t)j * 16384] = c;
            if (el == 0) STM[seq * 32 + j] = m;
            if (j < 31) { const float bsj = BS[seq * 32 + j], mlj = ML[seq * 32 + j]; const float mn = fmaxf(bsj + m, mlj);
                c = __expf(bsj + m - mn) * c + __expf(mlj - mn) * u[j]; m = mn; }
        }
    }
    for (int e = gid; e < 8 * 128; e += NT) {
        const int seq = e >> 7, el = e & 127;
        float c = 0.f, m = 0.f;
        for (int j = 0; j < 32; ++j) {
            STN[(seq * 32 + j) * 128 + el] = c;
            if (j < 31) { const float bsj = BS[seq * 32 + j], mlj = ML[seq * 32 + j]; const float mn = fmaxf(bsj + m, mlj);
                c = __expf(bsj + m - mn) * c + __expf(mlj - mn) * NU[(seq * 32 + j) * 128 + el]; m = mn; }
        }
    }
    const float* C1P = (const float*)(F.ws + WS_C1P); const float* C2P = (const float*)(F.ws + WS_C2P);
    float* C1 = (float*)(F.ws + WS_C1); float* C2 = (float*)(F.ws + WS_C2);
    for (int n = gid; n < FF; n += NT) { float s1 = 0.f, s2 = 0.f;
#pragma unroll
        for (int kb = 0; kb < 16; ++kb) { s1 += C1P[kb * FF + n]; s2 += C2P[kb * FF + n]; }
        C1[n] = s1; C2[n] = s2 + bff1[n]; }
}

constexpr int M3_Q = 0, M3_K = 16384, M3_V = 32768, M3_KW = 49152, M3_C = 65536, M3_S = 98304, M3_H = 0;
__device__ __forceinline__ void mlstm_stage3_item(Frame& F, const Args& A, int item) {
    const int tid = F.tid, lane = F.lane, wid = F.wave, r32 = lane & 31, hi = lane >> 5;
    const bf16* QB = (const bf16*)(F.ws + WS_QB); const bf16* KB = (const bf16*)(F.ws + WS_KB); const bf16* VB = (const bf16*)(F.ws + WS_VB); const bf16* OG = (const bf16*)(F.ws + WS_OG);
    const float* IG = (const float*)(F.ws + WS_IG); const float* LFp = (const float*)(F.ws + WS_LF);
    bf16* MIX = (bf16*)(F.ws + WS_MIX);
    const float* gn = A.in[10];
    int h, nch; long row0; const float* C0; const float* N0; float m0; bool zero_init = false;
    float* Cout; float* Nout; float* Mout; bool last;
    if (item < 256) {
        const int seq = item >> 5, j = item & 31, b = seq >> 2; h = seq & 3; row0 = (long)b * SEQ + (long)j * 512; nch = 8;
        C0 = (const float*)(F.ws + WS_STC) + (size_t)item * 16384; N0 = (const float*)(F.ws + WS_STN) + item * 128; m0 = ((const float*)(F.ws + WS_STM))[item];
        zero_init = (j == 0); last = (j == 31);
        Cout = F.out + O_CP + (size_t)seq * 16384; Nout = F.out + O_NP + seq * 128; Mout = F.out + O_MP + seq;
    } else {
        const int s = item - 256, db = s >> 2; h = s & 3; row0 = MP + (long)db * 64; nch = 1;
        C0 = A.in[4] + (size_t)s * 16384; N0 = A.in[5] + s * 128; m0 = A.in[6][s]; last = true;
        Cout = F.out + O_CS + (size_t)s * 16384; Nout = F.out + O_NS + s * 128; Mout = F.out + O_MS + s;
    }
    if (zero_init) m0 = 0.f;
    const int ntok = nch * 64;
    LAS unsigned char* lds = F.lds;
    LAS float* sA = (LAS float*)(lds + M3_S);
    LAS float* sPM = sA + 512;
    LAS float* sENM = sA + 1024;
    LAS float* sG = sA + 1536;
    LAS float* sWE = sA + 2048;
    LAS float* sDEC = sA + 2560;
    LAS float* red = sA + 2576;
    LAS bf16* snb = (LAS bf16*)(sA + 2624);
    const int kb = wid >> 1, vb0 = 2 * (wid & 1);
    const int th = wid >> 2, vq = wid & 3;
    const int trb = tr_read_base(lane);
    const bf16x8 ones = (bf16x8){0x3F80, 0x3F80, 0x3F80, 0x3F80, 0x3F80, 0x3F80, 0x3F80, 0x3F80};
    v4u qv[2], kv[2], vv[2];
    const int prow = tid >> 4, pc16 = tid & 15;
    const size_t poff = (size_t)(row0 + prow) * AW + h * 128 + pc16 * 8;
#pragma unroll
    for (int i = 0; i < 2; ++i) { qv[i] = *(const v4u*)(QB + poff + (size_t)i * 32 * AW); kv[i] = *(const v4u*)(KB + poff + (size_t)i * 32 * AW); vv[i] = *(const v4u*)(VB + poff + (size_t)i * 32 * AW); }
    float mfinal;
    {
        const bool valid = tid < ntok;
        const float lfv = valid ? LFp[(row0 + tid) * 4 + h] : 0.f, igv = valid ? IG[(row0 + tid) * 4 + h] : -1e30f;
        float bs = lfv;
#pragma unroll
        for (int off = 1; off < 64; off <<= 1) { const float t = __shfl_up(bs, off); if (lane >= off) bs += t; }
        if (lane == 63) red[wid] = bs;
        __syncthreads();
        float woff = 0.f;
#pragma unroll
        for (int w = 0; w < 8; ++w) { const float t = red[w]; if (w < wid) woff += t; }
        bs += woff;
        const float a = igv - bs;
        float pm = a;
#pragma unroll
        for (int off = 1; off < 64; off <<= 1) { const float t = __shfl_up(pm, off); if (lane >= off) pm = fmaxf(pm, t); }
        if (lane == 63) red[8 + wid] = pm;
        __syncthreads();
        float wmx = m0;
#pragma unroll
        for (int w = 0; w < 8; ++w) { const float t = red[8 + w]; if (w < wid) wmx = fmaxf(wmx, t); }
        pm = fmaxf(pm, wmx);
        sA[tid] = a; sPM[tid] = pm; sENM[tid] = __expf(-(bs + pm));
        mfinal = bs + pm;
        __syncthreads();
        const int c = tid >> 6;
        const float Mc = (c == 0) ? m0 : sPM[c * 64 - 1], PMe = sPM[c * 64 + 63];
        sG[tid] = __expf(Mc - pm); sWE[tid] = __expf(a - PMe);
        if ((tid & 63) == 0) sDEC[c] = __expf(Mc - PMe);
    }
    f32x16 cacc[2], nacc;
#pragma unroll
    for (int vi = 0; vi < 2; ++vi) { const int v = 32 * (vb0 + vi) + r32;
#pragma unroll
        for (int g4 = 0; g4 < 4; ++g4) { f32x4 x = (f32x4){0.f, 0.f, 0.f, 0.f}; if (!zero_init) x = *(const f32x4*)(C0 + v * 128 + 32 * kb + 8 * g4 + 4 * hi);
            cacc[vi][4 * g4] = x[0]; cacc[vi][4 * g4 + 1] = x[1]; cacc[vi][4 * g4 + 2] = x[2]; cacc[vi][4 * g4 + 3] = x[3];
            *(LAS v2u*)(lds + M3_C + (4 * kb + g4) * 2048 + v * 16 + hi * 8) = (v2u){pk2(x[0], x[1]), pk2(x[2], x[3])}; } }
#pragma unroll
    for (int g4 = 0; g4 < 4; ++g4) { f32x4 x = (f32x4){0.f, 0.f, 0.f, 0.f}; if (!zero_init) x = *(const f32x4*)(N0 + 32 * kb + 8 * g4 + 4 * hi);
        nacc[4 * g4] = x[0]; nacc[4 * g4 + 1] = x[1]; nacc[4 * g4 + 2] = x[2]; nacc[4 * g4 + 3] = x[3]; }
    if ((wid & 1) == 0 && r32 == 0) {
#pragma unroll
        for (int g4 = 0; g4 < 4; ++g4) *(LAS v2u*)(snb + 32 * kb + 8 * g4 + 4 * hi) = (v2u){pk2(nacc[4 * g4], nacc[4 * g4 + 1]), pk2(nacc[4 * g4 + 2], nacc[4 * g4 + 3])};
    }
    __syncthreads();
    for (int c = 0; c < nch; ++c) {
        const long rowc = row0 + c * 64;
#pragma unroll
        for (int i = 0; i < 2; ++i) { const int row = prow + 32 * i;
            *(LAS v4u*)(lds + M3_Q + pc16 * 1024 + row * 16) = qv[i]; *(LAS v4u*)(lds + M3_K + pc16 * 1024 + row * 16) = kv[i]; *(LAS v4u*)(lds + M3_V + tr_off(row, pc16)) = vv[i];
            *(LAS v4u*)(lds + M3_KW + tr_off(row, pc16)) = scale8(kv[i], sWE[c * 64 + row]); }
        const int lt = tid >> 3, lpart = tid & 7;
        const size_t ogoff = (size_t)(rowc + lt) * AW + h * 128 + lpart * 16;
        const v4u og0 = *(const v4u*)(OG + ogoff), og1 = *(const v4u*)(OG + ogoff + 8);
        if (c + 1 < nch) {
#pragma unroll
            for (int i = 0; i < 2; ++i) { const size_t o2 = poff + (size_t)((c + 1) * 64 + i * 32) * AW; qv[i] = *(const v4u*)(QB + o2); kv[i] = *(const v4u*)(KB + o2); vv[i] = *(const v4u*)(VB + o2); }
        }
        __syncthreads();
        bf16x8 qf[8];
#pragma unroll
        for (int d0 = 0; d0 < 8; ++d0) qf[d0] = *(const LAS bf16x8*)(lds + M3_Q + (2 * d0 + hi) * 1024 + (32 * th + r32) * 16);
        v4u pw[4];
        const int tt = 32 * th + r32; const float pmt = sPM[c * 64 + tt];
#pragma unroll
        for (int sh = 0; sh < 2; ++sh) {
            f32x16 p;
#pragma unroll
            for (int r = 0; r < 16; ++r) p[r] = 0.f;
#pragma unroll
            for (int d0 = 0; d0 < 8; ++d0) { const bf16x8 kf = *(const LAS bf16x8*)(lds + M3_K + (2 * d0 + hi) * 1024 + (32 * sh + r32) * 16);
                p = __builtin_amdgcn_mfma_f32_32x32x16_bf16(kf, qf[d0], p, 0, 0, 0); }
#pragma unroll
            for (int g4 = 0; g4 < 4; ++g4) { const f32x4 av = *(const LAS f32x4*)(sA + c * 64 + 32 * sh + 8 * g4 + 4 * hi);
#pragma unroll
                for (int e = 0; e < 4; ++e) { const int s = 32 * sh + 8 * g4 + 4 * hi + e; const float w = (s <= tt) ? __expf(av[e] - pmt) : 0.f; p[4 * g4 + e] *= w; } }
            pw[2 * sh] = (v4u){cvt_pk_bf16(p[0], p[1]), cvt_pk_bf16(p[2], p[3]), cvt_pk_bf16(p[4], p[5]), cvt_pk_bf16(p[6], p[7])};
            pw[2 * sh + 1] = (v4u){cvt_pk_bf16(p[8], p[9]), cvt_pk_bf16(p[10], p[11]), cvt_pk_bf16(p[12], p[13]), cvt_pk_bf16(p[14], p[15])};
        }
        f32x16 num, den;
#pragma unroll
        for (int r = 0; r < 16; ++r) { num[r] = 0.f; den[r] = 0.f; }
#pragma unroll
        for (int d0 = 0; d0 < 8; ++d0) { const bf16x8 cf = *(const LAS bf16x8*)(lds + M3_C + (2 * d0 + hi) * 2048 + (32 * vq + r32) * 16);
            const bf16x8 nf = *(const LAS bf16x8*)(snb + 16 * d0 + 8 * hi);
            num = __builtin_amdgcn_mfma_f32_32x32x16_bf16(qf[d0], cf, num, 0, 0, 0);
            den = __builtin_amdgcn_mfma_f32_32x32x16_bf16(qf[d0], nf, den, 0, 0, 0); }
#pragma unroll
        for (int g4 = 0; g4 < 4; ++g4) { const f32x4 gv = *(const LAS f32x4*)(sG + c * 64 + 32 * th + 8 * g4 + 4 * hi);
#pragma unroll
            for (int e = 0; e < 4; ++e) { num[4 * g4 + e] *= gv[e]; den[4 * g4 + e] *= gv[e]; } }
#pragma unroll
        for (int ks = 0; ks < 4; ++ks) { const bf16x8 vf = trfrag(lds + M3_V + vq * 4096 + ks * 1024 + trb); const bf16x8 pa = __builtin_bit_cast(bf16x8, pw[ks]);
            num = __builtin_amdgcn_mfma_f32_32x32x16_bf16(pa, vf, num, 0, 0, 0);
            den = __builtin_amdgcn_mfma_f32_32x32x16_bf16(pa, ones, den, 0, 0, 0); }
#pragma unroll
        for (int g4 = 0; g4 < 4; ++g4) { const f32x4 ev = *(const LAS f32x4*)(sENM + c * 64 + 32 * th + 8 * g4 + 4 * hi);
#pragma unroll
            for (int e = 0; e < 4; ++e) num[4 * g4 + e] *= __builtin_amdgcn_rcpf(fmaxf(fabsf(den[4 * g4 + e]), ev[e])); }
        __syncthreads();
#pragma unroll
        for (int g4 = 0; g4 < 4; ++g4)
#pragma unroll
            for (int e = 0; e < 4; ++e) { const int t = 32 * th + 8 * g4 + 4 * hi + e; *(LAS float*)(lds + M3_H + (t * 128 + 32 * vq + r32) * 4) = num[4 * g4 + e]; }
        const float decay = sDEC[c];
#pragma unroll
        for (int r = 0; r < 16; ++r) { cacc[0][r] *= decay; cacc[1][r] *= decay; nacc[r] *= decay; }
#pragma unroll
        for (int ks = 0; ks < 4; ++ks) { const bf16x8 af = trfrag(lds + M3_KW + kb * 4096 + ks * 1024 + trb);
#pragma unroll
            for (int vi = 0; vi < 2; ++vi) { const bf16x8 bfr = trfrag(lds + M3_V + (vb0 + vi) * 4096 + ks * 1024 + trb);
                cacc[vi] = __builtin_amdgcn_mfma_f32_32x32x16_bf16(af, bfr, cacc[vi], 0, 0, 0); }
            nacc = __builtin_amdgcn_mfma_f32_32x32x16_bf16(af, ones, nacc, 0, 0, 0); }
#pragma unroll
        for (int vi = 0; vi < 2; ++vi) { const int v = 32 * (vb0 + vi) + r32;
#pragma unroll
            for (int g4 = 0; g4 < 4; ++g4) *(LAS v2u*)(lds + M3_C + (4 * kb + g4) * 2048 + v * 16 + hi * 8) = (v2u){pk2(cacc[vi][4 * g4], cacc[vi][4 * g4 + 1]), pk2(cacc[vi][4 * g4 + 2], cacc[vi][4 * g4 + 3])}; }
        if ((wid & 1) == 0 && r32 == 0) {
#pragma unroll
            for (int g4 = 0; g4 < 4; ++g4) *(LAS v2u*)(snb + 32 * kb + 8 * g4 + 4 * hi) = (v2u){pk2(nacc[4 * g4], nacc[4 * g4 + 1]), pk2(nacc[4 * g4 + 2], nacc[4 * g4 + 3])};
        }
        __syncthreads();
        { f32x4 x[4]; float s = 0.f;
#pragma unroll
          for (int i = 0; i < 4; ++i) { x[i] = *(const LAS f32x4*)(lds + M3_H + (lt * 128 + lpart * 16 + 4 * i) * 4); s += (x[i][0] + x[i][1]) + (x[i][2] + x[i][3]); }
          s += __shfl_xor(s, 1); s += __shfl_xor(s, 2); s += __shfl_xor(s, 4);
          const float mean = s * (1.f / 128.f); float q = 0.f;
#pragma unroll
          for (int i = 0; i < 4; ++i) { x[i] = x[i] - mean; q += (x[i][0] * x[i][0] + x[i][1] * x[i][1]) + (x[i][2] * x[i][2] + x[i][3] * x[i][3]); }
          q += __shfl_xor(q, 1); q += __shfl_xor(q, 2); q += __shfl_xor(q, 4);
          const float rstd = 1.0f / sqrtf(q * (1.f / 128.f) + LN_EPS);
          const float* gp = gn + h * 128 + lpart * 16;
          const f32x4 g0 = *(const f32x4*)gp, g1 = *(const f32x4*)(gp + 4), g2 = *(const f32x4*)(gp + 8), g3 = *(const f32x4*)(gp + 12);
          v4u o0, o1;
          o0.x = pk2(x[0][0] * rstd * g0[0] * bflo(og0.x), x[0][1] * rstd * g0[1] * bfhi(og0.x)); o0.y = pk2(x[0][2] * rstd * g0[2] * bflo(og0.y), x[0][3] * rstd * g0[3] * bfhi(og0.y));
          o0.z = pk2(x[1][0] * rstd * g1[0] * bflo(og0.z), x[1][1] * rstd * g1[1] * bfhi(og0.z)); o0.w = pk2(x[1][2] * rstd * g1[2] * bflo(og0.w), x[1][3] * rstd * g1[3] * bfhi(og0.w));
          o1.x = pk2(x[2][0] * rstd * g2[0] * bflo(og1.x), x[2][1] * rstd * g2[1] * bfhi(og1.x)); o1.y = pk2(x[2][2] * rstd * g2[2] * bflo(og1.y), x[2][3] * rstd * g2[3] * bfhi(og1.y));
          o1.z = pk2(x[3][0] * rstd * g3[0] * bflo(og1.z), x[3][1] * rstd * g3[1] * bfhi(og1.z)); o1.w = pk2(x[3][2] * rstd * g3[2] * bflo(og1.w), x[3][3] * rstd * g3[3] * bfhi(og1.w));
          bf16* mp = MIX + (size_t)(rowc + lt) * DM + 512 + h * 128 + lpart * 16;
          *(v4u*)mp = o0; *(v4u*)(mp + 8) = o1; }
        __syncthreads();
    }
    if (last) {
#pragma unroll
        for (int vi = 0; vi < 2; ++vi) { const int v = 32 * (vb0 + vi) + r32;
#pragma unroll
            for (int g4 = 0; g4 < 4; ++g4) *(f32x4*)(Cout + v * 128 + 32 * kb + 8 * g4 + 4 * hi) = (f32x4){cacc[vi][4 * g4], cacc[vi][4 * g4 + 1], cacc[vi][4 * g4 + 2], cacc[vi][4 * g4 + 3]}; }
        if ((wid & 1) == 0 && r32 == 0) {
#pragma unroll
            for (int g4 = 0; g4 < 4; ++g4) *(f32x4*)(Nout + 32 * kb + 8 * g4 + 4 * hi) = (f32x4){nacc[4 * g4], nacc[4 * g4 + 1], nacc[4 * g4 + 2], nacc[4 * g4 + 3]};
        }
        if (tid == ntok - 1) Mout[0] = mfinal;
    }
    __syncthreads();
}

__device__ __forceinline__ void p8_final_ln(Frame& F, const float* g2, const float* b2) {
    const int gw = F.vcu * 8 + F.wave, NGW = F.G * 8;
    f32x4 gg[4], bb[4];
#pragma unroll
    for (int j = 0; j < 4; ++j) { gg[j] = *(const f32x4*)(g2 + 256 * j + 4 * F.lane); bb[j] = *(const f32x4*)(b2 + 256 * j + 4 * F.lane); }
    for (int m = gw; m < MT; m += NGW) {
        GAS f32x4* xr = (GAS f32x4*)(F.out + (size_t)m * DM) + F.lane;
        f32x4 v[4]; float s = 0.f;
#pragma unroll
        for (int j = 0; j < 4; ++j) { v[j] = xr[64 * j]; s += (v[j][0] + v[j][1]) + (v[j][2] + v[j][3]); }
        const float mean = wave_sum(s) * (1.f / DM); float s2 = 0.f;
#pragma unroll
        for (int j = 0; j < 4; ++j) { v[j] = v[j] - mean; s2 += (v[j][0] * v[j][0] + v[j][1] * v[j][1]) + (v[j][2] * v[j][2] + v[j][3] * v[j][3]); }
        const float rstd = 1.f / sqrtf(wave_sum(s2) * (1.f / DM) + LN_EPS);
#pragma unroll
        for (int j = 0; j < 4; ++j) xr[64 * j] = v[j] * rstd * gg[j] + bb[j];
    }
}

#define XB_TMO      128
#define XB_XCNT(j)  (256  + 64 * (j))
#define XB_XSUB(j)  (1280 + 64 * (j))
#define XB_XGEN(j)  (2304 + 64 * (j))
#define XB_TOP      3328
#define XB_TOPGEN   3392
#define XCD_BAR_WORDS 3456
#define XB_SPIN_CAP (1u << 18)
__device__ __forceinline__ unsigned xb_ld(unsigned* p)              { return __hip_atomic_load(p, __ATOMIC_RELAXED, __HIP_MEMORY_SCOPE_AGENT); }
__device__ __forceinline__ unsigned xb_add(unsigned* p, unsigned v) { return __hip_atomic_fetch_add(p, v, __ATOMIC_RELAXED, __HIP_MEMORY_SCOPE_AGENT); }
__device__ __forceinline__ unsigned xb_xcc_id() { return (unsigned)__builtin_amdgcn_s_getreg((3 << 11) | 20) & 0xFu; }
#define XB_SPIN(cond, bar) do { unsigned _sp = 0; while (cond) { __builtin_amdgcn_s_sleep(1); \
    if ((++_sp & 255u) == 0u) { if (xb_ld(&(bar)[XB_TMO])) break; if (_sp > XB_SPIN_CAP) { atomicAdd(&(bar)[XB_TMO], 1u); break; } } } } while (0)
struct XcdBarrier { unsigned* bar; unsigned x; volatile LAS unsigned* st; };
__device__ __forceinline__ XcdBarrier xcd_barrier_post(unsigned* bar, volatile LAS unsigned* st) {
    XcdBarrier b; b.bar = bar; b.x = xb_xcc_id(); b.st = st;
    if (threadIdx.x == 0) (void)xb_add(&bar[XB_XCNT(b.x)], 1u);
    return b;
}
__device__ __forceinline__ void xcd_barrier_complete(unsigned* bar, unsigned x, unsigned& nloc, unsigned& nx) {
    const unsigned G = gridDim.x * gridDim.y * gridDim.z;
    unsigned sum, cnt, mine, sp = 0u;
    for (;;) {
        sum = 0u; cnt = 0u; mine = 0u;
#pragma unroll
        for (unsigned j = 0; j < 16; ++j) { const unsigned c = xb_ld(&bar[XB_XCNT(j)]); sum += c; cnt += (c > 0u) ? 1u : 0u; mine = (j == x) ? c : mine; }
        if (sum == G) break;
        __builtin_amdgcn_s_sleep(1);
        if ((++sp & 255u) == 0u) { if (xb_ld(&bar[XB_TMO])) break; if (sp > XB_SPIN_CAP) { atomicAdd(&bar[XB_TMO], 1u); break; } }
    }
    nloc = mine > 0u ? mine : 1u; nx = cnt > 0u ? cnt : 1u;
}
__device__ __forceinline__ void xcd_barrier(const XcdBarrier& b) {
    asm volatile("s_waitcnt vmcnt(0)" ::: "memory");
    __syncthreads();
    if (threadIdx.x == 0) {
        unsigned* bar = b.bar;
        __builtin_amdgcn_s_waitcnt(0);
        unsigned nloc = b.st[0], nx = b.st[1];
        if (nloc == 0u) { xcd_barrier_complete(bar, b.x, nloc, nx); b.st[0] = nloc; b.st[1] = nx; }
        const unsigned old = xb_add(&bar[XB_XSUB(b.x)], 1u);
        const unsigned gen = old / nloc;
        if (old + 1u == (gen + 1u) * nloc) {
            __builtin_amdgcn_fence(__ATOMIC_RELEASE, "agent");
            asm volatile("s_waitcnt vmcnt(0)" ::: "memory");
            const unsigned og = xb_add(&bar[XB_TOP], 1u);
            const unsigned tg = og / nx;
            if (og + 1u == (tg + 1u) * nx) xb_add(&bar[XB_TOPGEN], 1u);
            else XB_SPIN(xb_ld(&bar[XB_TOPGEN]) == tg, bar);
            __builtin_amdgcn_fence(__ATOMIC_ACQUIRE, "agent");
            xb_add(&bar[XB_XGEN(b.x)], 1u);
            asm volatile("s_waitcnt vmcnt(0)" ::: "memory");
        } else {
            XB_SPIN(xb_ld(&bar[XB_XGEN(b.x)]) == gen, bar);
            __builtin_amdgcn_fence(__ATOMIC_ACQUIRE, "agent");
            asm volatile("s_waitcnt vmcnt(0)" ::: "memory");
        }
    }
    __syncthreads();
}

constexpr int N_PHASES = 9;

__global__ void __launch_bounds__(512, 2) hybrid_fwd(Args args) {
    extern __shared__ __attribute__((aligned(16))) unsigned char lds_raw[];
    Frame F;
    F.lds = (LAS unsigned char*)lds_raw;
    F.tid = threadIdx.x; F.lane = F.tid & 63; F.wave = __builtin_amdgcn_readfirstlane(F.tid >> 6);
    F.G = gridDim.x; { const int bx = blockIdx.x; F.vcu = (F.G % 8 == 0) ? (bx % 8) * (F.G / 8) + bx / 8 : bx; }
    F.out = args.out; F.ws = args.ws;
    const int lo = args.ph_lo, hi = args.ph_hi;
#define IN(k) (lo <= (k) && (k) < hi)
#define BOTH(k) (IN(k) && IN((k) + 1))
#define GRID_BAR() do { xcd_barrier(bar); if (DUP_PHASE == 99) xcd_barrier(bar); } while (0)
    for (int u = F.tid; u < (LDS_BYTES - RING_BYTES) / 4; u += 512) ((LAS unsigned*)(F.lds + RING_BYTES))[u] = 0u;
    __syncthreads();
    XcdBarrier bar; bar.bar = (unsigned*)(F.ws + WS_CTL) + CW_BAR; bar.x = 0; bar.st = nullptr;
    if (hi - lo > 1) bar = xcd_barrier_post((unsigned*)(F.ws + WS_CTL) + CW_BAR, (volatile LAS unsigned*)(F.lds + MISC_OFF) + 8);

    if (IN(0)) { p0_prologue(F, args); if (DUP_PHASE == 10) { __syncthreads(); p0_prologue(F, args); } if (BOTH(0)) GRID_BAR(); }

    if (IN(1)) {
        pg8::Gemm g{(const bf16*)(F.ws + WS_XB), (const bf16*)(F.ws + WS_WIN), MP, NIN, DM}; pg8::StaticOrder S; S.init(MP, NIN, F.G, (int)blockIdx.x);
        EpiInProj E; E.ws = F.ws; E.bias = args.in[8];
        static_assert(WS_KA == WS_QA + 33 * MiB && WS_VA == WS_QA + 70 * MiB && WS_QB == WS_QA + 107 * MiB && WS_KB == WS_QA + 140 * MiB && WS_VB == WS_QA + 173 * MiB && WS_OG == WS_QA + 206 * MiB, "slice map");
        E.out = F.out;
        pg8::gemm_phase<EpiInProj, pg8::StaticOrder, true, true>(F.lds, g, S, E);
        if (DUP_PHASE == 1) pg8::gemm_phase<EpiInProj, pg8::StaticOrder, true, true>(F.lds, g, S, E);
        { SEpiInProj SE{F.ws, args.in[8], F.out};
          for (int rep = 0; rep < (DUP_PHASE == 11 ? 2 : 1); ++rep) small_gemm_phase(F, (const bf16*)(F.ws + WS_XB) + (size_t)MP * DM, (const bf16*)(F.ws + WS_WIN), NIN, DM, SE); }
        if (BOTH(1)) GRID_BAR();
    }

    if (IN(2)) {
        const bf16* QA = (const bf16*)(F.ws + WS_QA); const bf16* KA = (const bf16*)(F.ws + WS_KA); const bf16* VA = (const bf16*)(F.ws + WS_VA); bf16* MIX = (bf16*)(F.ws + WS_MIX);
        for (int rep = 0; rep < (DUP_PHASE == 20 ? 2 : 1); ++rep) {
        for (int id = F.vcu * 4; id < 1024; id += F.G * 4)
            for (int k = 0; k < 4; ++k) { const int uid = id + k, bh = uid >> 6, qb = uid & 63, b = bh >> 3, h = bh & 7;
                const int ilo = (8 - 4 * qb) > 0 ? (8 - 4 * qb) : 0;
                attn_unit(F, QA, KA, VA, MIX, args.in[9], h, (long)b * SEQ + 256 * qb, (long)b * SEQ + 64 * (4 * qb - 8), ilo, 11, 8, k == 0); }
        for (int uid = F.vcu; uid < 64; uid += F.G) { const int db = uid >> 3, h = uid & 7;
            attn_unit(F, QA, KA, VA, MIX, args.in[9], h, (long)MP + 64 * db, (long)MP + 576 * db, 0, 8, 2, true); }
        }
        for (int rep = 0; rep < (DUP_PHASE == 21 ? 2 : 1); ++rep)
        for (int it = F.vcu; it < 256; it += F.G) mlstm_stage1_item(F, it);
        if (BOTH(2)) GRID_BAR();
    }

    if (IN(3)) { p3_scan(F, args.in[15]); if (DUP_PHASE == 3) p3_scan(F, args.in[15]); if (BOTH(3)) GRID_BAR(); }

    if (IN(4)) { for (int rep = 0; rep < (DUP_PHASE == 4 ? 2 : 1); ++rep) for (int it = F.vcu; it < 288; it += F.G) mlstm_stage3_item(F, args, it); if (BOTH(4)) GRID_BAR(); }

    if (IN(5)) {
        pg8::Gemm g{(const bf16*)(F.ws + WS_MIX), (const bf16*)(F.ws + WS_WOUT), MP, DM, DM}; pg8::StaticOrder S; S.init(MP, DM, F.G, (int)blockIdx.x);
        EpiZ1 E{args.in[0], args.in[1], (bf16*)(F.ws + WS_Z1), (float*)(F.ws + WS_STAT1), true};
        pg8::gemm_phase<EpiZ1, pg8::StaticOrder, true, true>(F.lds, g, S, E);
        if (DUP_PHASE == 5) { E.do_stat = false; pg8::gemm_phase<EpiZ1, pg8::StaticOrder, true, true>(F.lds, g, S, E); }
        { SEpiZ1 SE{args.in[1], (bf16*)(F.ws + WS_Z1), (float*)(F.ws + WS_STAT1)};
          small_gemm_phase(F, (const bf16*)(F.ws + WS_MIX) + (size_t)MP * DM, (const bf16*)(F.ws + WS_WOUT), DM, DM, SE); }
        if (BOTH(5)) GRID_BAR();
    }

    if (IN(6)) {
        pg8::Gemm g{(const bf16*)(F.ws + WS_Z1), (const bf16*)(F.ws + WS_W1), MP, FF, DM}; pg8::StaticOrder S; S.init(MP, FF, F.G, (int)blockIdx.x);
        EpiFfn1 E{(const float*)(F.ws + WS_STAT1), (const float*)(F.ws + WS_C1), (const float*)(F.ws + WS_C2), (bf16*)(F.ws + WS_HID)};
        pg8::gemm_phase<EpiFfn1, pg8::StaticOrder, true, true>(F.lds, g, S, E);
        if (DUP_PHASE == 6) pg8::gemm_phase<EpiFfn1, pg8::StaticOrder, true, true>(F.lds, g, S, E);
        { SEpiFfn1 SE{(const float*)(F.ws + WS_STAT1), (const float*)(F.ws + WS_C1), (const float*)(F.ws + WS_C2), (bf16*)(F.ws + WS_HID)};
          for (int rep = 0; rep < (DUP_PHASE == 16 ? 2 : 1); ++rep) small_gemm_phase(F, (const bf16*)(F.ws + WS_Z1) + (size_t)MP * DM, (const bf16*)(F.ws + WS_W1), FF, DM, SE); }
        if (BOTH(6)) GRID_BAR();
    }

    if (IN(7)) {
        pg8::Gemm g{(const bf16*)(F.ws + WS_HID), (const bf16*)(F.ws + WS_W2), MP, DM, FF}; pg8::StaticOrder S; S.init(MP, DM, F.G, (int)blockIdx.x);
        EpiFfn2 E{(const float*)(F.ws + WS_STAT1), (const bf16*)(F.ws + WS_Z1), args.in[12], args.in[13], args.in[17], F.out};
        pg8::gemm_phase<EpiFfn2, pg8::StaticOrder, true, true>(F.lds, g, S, E);
        if (DUP_PHASE == 7) pg8::gemm_phase<EpiFfn2, pg8::StaticOrder, true, true>(F.lds, g, S, E);
        { SEpiFfn2 SE{(const float*)(F.ws + WS_STAT1), (const bf16*)(F.ws + WS_Z1), args.in[12], args.in[13], args.in[17], F.out};
          for (int rep = 0; rep < (DUP_PHASE == 17 ? 2 : 1); ++rep) small_gemm_phase(F, (const bf16*)(F.ws + WS_HID) + (size_t)MP * FF, (const bf16*)(F.ws + WS_W2), DM, FF, SE); }
        if (BOTH(7)) GRID_BAR();
    }

    if (IN(8)) { p8_final_ln(F, args.in[18], args.in[19]); }
#undef IN
#undef BOTH
#undef GRID_BAR
}

extern "C" void kernel_launch(void* const* d_in, const int* in_sizes, int n_in, void* d_out, int out_size, void* d_ws, size_t ws_size, hipStream_t stream) {
    static int grid = 0;
    if (grid == 0) {
        if (n_in != 20 || out_size != (int)O_END || ws_size < WS_END) { fprintf(stderr, "kernel_launch: unexpected shapes: n_in %d out %d ws %zu (need %zu)\n", n_in, out_size, ws_size, (size_t)WS_END); grid = -1; return; }
        int dev = 0, cus = 0, per_cu = 0;
        if (hipGetDevice(&dev) != hipSuccess || hipDeviceGetAttribute(&cus, hipDeviceAttributeMultiprocessorCount, dev) != hipSuccess) { grid = -1; return; }
        if (hipFuncSetAttribute((const void*)hybrid_fwd, hipFuncAttributeMaxDynamicSharedMemorySize, LDS_BYTES) != hipSuccess) { fprintf(stderr, "kernel_launch: hipFuncSetAttribute failed\n"); grid = -1; return; }
        if (hipOccupancyMaxActiveBlocksPerMultiprocessor(&per_cu, (const void*)hybrid_fwd, 512, LDS_BYTES) != hipSuccess || per_cu < 1) { fprintf(stderr, "kernel_launch: occupancy query says %d\n", per_cu); (void)hipGetLastError(); grid = -1; return; }
        grid = cus;
    }
    if (grid < 0) return;
    if (hipMemsetAsync((char*)d_ws + WS_CTL, 0, CTL_ZERO_BYTES, stream) != hipSuccess) { fprintf(stderr, "kernel_launch: hipMemsetAsync failed\n"); return; }
    Args a{};
    for (int i = 0; i < 20; ++i) a.in[i] = (const float*)d_in[i];
    a.out = (float*)d_out; a.ws = (unsigned char*)d_ws;
#if MK_N_LAUNCHES == 1
    a.ph_lo = 0; a.ph_hi = N_PHASES; a.coop = 1;
    void* kargs[] = {&a};
    hipError_t e = hipLaunchCooperativeKernel((const void*)hybrid_fwd, dim3(grid), dim3(512), kargs, LDS_BYTES, stream);
    if (e != hipSuccess) fprintf(stderr, "kernel_launch: cooperative launch failed: %s (grid %d)\n", hipGetErrorString(e), grid);
#else
    for (int p = 0; p < N_PHASES; ++p) {
        a.ph_lo = p; a.ph_hi = p + 1; a.coop = 0;
        hipLaunchKernelGGL(hybrid_fwd, dim3(grid), dim3(512), LDS_BYTES, stream, a);
    }
#endif
}
```
